# Optimizing an MI355X kernel written in HIP

```python
import math
import jax, jax.numpy as jnp
from jax import lax
import numpy as np

D_MODEL = 1024
BATCH = 8
SEQ = 2048
DEPTH = 1

RMS_EPS = 1e-6
NEG_INF = -1e30

S5_WIDTH = D_MODEL // 2
S5_GROUP = 16
S5_GROUPS = S5_WIDTH // S5_GROUP
S5_STATE = 64

N_Q_HEADS = 16
N_KV_HEADS = 4
HEAD_DIM = 64
Q_PER_KV = N_Q_HEADS // N_KV_HEADS
WINDOW = 128
ATTN_BLOCK = 128
N_BUCKETS = 32
MAX_DISTANCE = 128

PEER_HEADS = 8
PEER_KEY_DIM = 128
N_SUB_KEYS = 128
N_EXPERTS = N_SUB_KEYS * N_SUB_KEYS
PEER_TOPK = 16
PEER_TOKEN_BLOCK = 128

Q_WIDTH = N_Q_HEADS * HEAD_DIM
KV_WIDTH = N_KV_HEADS * HEAD_DIM
GATE_WIDTH = 2 * D_MODEL
IN_WIDTH = S5_WIDTH + Q_WIDTH + 2 * KV_WIDTH + GATE_WIDTH

kernel_name = "hybrid_s5_swa_peer_block"


def rms_norm(x, g):
    xf = x.astype(jnp.float32)
    r = lax.rsqrt(jnp.mean(xf * xf, axis=-1, keepdims=True) + RMS_EPS)
    return (xf * r).astype(x.dtype) * g


def _complex_scan_combine(c1, c2):
    a1r, a1i, b1r, b1i = c1
    a2r, a2i, b2r, b2i = c2
    ar = a2r * a1r - a2i * a1i
    ai = a2r * a1i + a2i * a1r
    br = a2r * b1r - a2i * b1i + b2r
    bi = a2r * b1i + a2i * b1r + b2i
    return (ar, ai, br, bi)


def s5_mixer(u, lam_re, lam_im, log_step, b_re, b_im, c_re, c_im, d_skip, w_glu):
    bsz, seq, _ = u.shape
    f32 = jnp.float32
    uf = u.astype(f32).reshape(bsz, seq, S5_GROUPS, S5_GROUP)
    lr, li = lam_re.astype(f32), lam_im.astype(f32)
    step = jnp.exp(log_step.astype(f32))[:, None]
    mag = jnp.exp(lr * step)
    abar_re = mag * jnp.cos(li * step)
    abar_im = mag * jnp.sin(li * step)
    den = lr * lr + li * li
    nr, ni = abar_re - 1.0, abar_im
    coef_re = ((nr * lr + ni * li) / den)[..., None]
    coef_im = ((ni * lr - nr * li) / den)[..., None]
    br, bi = b_re.astype(f32), b_im.astype(f32)
    bbar_re = coef_re * br - coef_im * bi
    bbar_im = coef_re * bi + coef_im * br
    bu_re = jnp.einsum('blgc,gpc->blgp', uf, bbar_re)
    bu_im = jnp.einsum('blgc,gpc->blgp', uf, bbar_im)
    a_re = jnp.broadcast_to(abar_re, bu_re.shape)
    a_im = jnp.broadcast_to(abar_im, bu_im.shape)
    _, _, h_re, h_im = lax.associative_scan(
        _complex_scan_combine, (a_re, a_im, bu_re, bu_im), axis=1)
    y = (jnp.einsum('blgp,gcp->blgc', h_re, c_re.astype(f32))
         - jnp.einsum('blgp,gcp->blgc', h_im, c_im.astype(f32))
         + d_skip.astype(f32) * uf)
    y = jax.nn.gelu(y.reshape(bsz, seq, S5_WIDTH), approximate=False).astype(u.dtype)
    ab = y @ w_glu
    a, b = jnp.split(ab, 2, axis=-1)
    return a * jax.nn.sigmoid(b)


def t5_bucket(dist):
    max_exact = N_BUCKETS // 2
    d_f = jnp.maximum(dist, 1).astype(jnp.float32)
    large = max_exact + (jnp.log(d_f / max_exact) / math.log(MAX_DISTANCE / max_exact)
                         * (N_BUCKETS - max_exact)).astype(jnp.int32)
    large = jnp.minimum(large, N_BUCKETS - 1)
    return jnp.where(dist < max_exact, dist, large)


def sliding_window_attention(q, k, v, q_norm_g, k_norm_g, rel_bias_table, sinks):
    bsz, seq, _ = q.shape
    nb = seq // ATTN_BLOCK
    q = rms_norm(q.reshape(bsz, seq, N_KV_HEADS, Q_PER_KV, HEAD_DIM), q_norm_g)
    k = rms_norm(k.reshape(bsz, seq, N_KV_HEADS, HEAD_DIM), k_norm_g)
    v = v.reshape(bsz, seq, N_KV_HEADS, HEAD_DIM)
    qb = q.reshape(bsz, nb, ATTN_BLOCK, N_KV_HEADS, Q_PER_KV, HEAD_DIM)

    def band(t):
        pad = jnp.pad(t, ((0, 0), (ATTN_BLOCK, 0), (0, 0), (0, 0)))
        prev = pad[:, :seq].reshape(bsz, nb, ATTN_BLOCK, N_KV_HEADS, HEAD_DIM)
        cur = t.reshape(bsz, nb, ATTN_BLOCK, N_KV_HEADS, HEAD_DIM)
        return jnp.concatenate([prev, cur], axis=2)

    kb, vb = band(k), band(v)
    scale = HEAD_DIM ** -0.5
    scores = jnp.einsum('bnqkgd,bnskd->bnkgqs', qb, kb).astype(jnp.float32) * scale

    qi = jnp.arange(ATTN_BLOCK)[:, None]
    si = jnp.arange(2 * ATTN_BLOCK)[None, :]
    dist = ATTN_BLOCK + qi - si
    band_ok = (dist >= 0) & (dist < WINDOW)
    bias = rel_bias_table.astype(jnp.float32)[t5_bucket(jnp.maximum(dist, 0))]
    bias = bias.transpose(2, 0, 1).reshape(N_KV_HEADS, Q_PER_KV, ATTN_BLOCK, 2 * ATTN_BLOCK)
    blk = jnp.arange(nb)[:, None, None]
    key_ok = (blk - 1) * ATTN_BLOCK + si[None] >= 0
    valid = (band_ok[None] & key_ok)[None, :, None, None]

    scores = jnp.where(valid, scores + bias, NEG_INF)
    sink = sinks.astype(jnp.float32).reshape(1, 1, N_KV_HEADS, Q_PER_KV, 1, 1)
    m = jnp.maximum(jnp.max(scores, axis=-1, keepdims=True), sink)
    p = jnp.exp(scores - m)
    p = p / (jnp.sum(p, axis=-1, keepdims=True) + jnp.exp(sink - m))
    out = jnp.einsum('bnkgqs,bnskd->bnqkgd', p.astype(vb.dtype), vb)
    return out.reshape(bsz, seq, Q_WIDTH)


def peer_mixer(xn, w_query, sub_keys, u_tab, v_tab):
    bsz, seq, d = xn.shape
    t = bsz * seq
    xt = xn.reshape(t, d)
    q = (xt @ w_query).reshape(t, PEER_HEADS, 2, PEER_KEY_DIM // 2)
    s = jnp.einsum('thkd,hknd->thkn', q, sub_keys).astype(jnp.float32)
    vals, idx = lax.top_k(s, PEER_TOPK)
    cand = (vals[:, :, 0, :, None] + vals[:, :, 1, None, :]).reshape(t, PEER_HEADS, PEER_TOPK * PEER_TOPK)
    best, pos = lax.top_k(cand, PEER_TOPK)
    i1 = jnp.take_along_axis(idx[:, :, 0], pos // PEER_TOPK, axis=-1)
    i2 = jnp.take_along_axis(idx[:, :, 1], pos % PEER_TOPK, axis=-1)
    expert = (i1 * N_SUB_KEYS + i2).reshape(t, PEER_HEADS * PEER_TOPK)
    gate = jax.nn.softmax(best, axis=-1).reshape(t, PEER_HEADS * PEER_TOPK)

    def block_fn(args):
        xb, eb, gb = args
        a = jnp.einsum('cd,ced->ce', xb, u_tab[eb]).astype(jnp.float32)
        w = (gb * jax.nn.gelu(a, approximate=False)).astype(xb.dtype)
        return jnp.einsum('ce,ced->cd', w, v_tab[eb])

    nblk = t // PEER_TOKEN_BLOCK
    out = lax.map(block_fn, (xt.reshape(nblk, PEER_TOKEN_BLOCK, d),
                             expert.reshape(nblk, PEER_TOKEN_BLOCK, -1),
                             gate.reshape(nblk, PEER_TOKEN_BLOCK, -1)))
    return out.reshape(bsz, seq, d)


def setup_inputs(seed: int = 0) -> dict:
    key = jax.random.key(seed)
    ks = jax.random.split(key, 26)
    f32 = jnp.float32
    L, D, G, P, C = DEPTH, D_MODEL, S5_GROUPS, S5_STATE, S5_GROUP
    nrm = lambda k, shape, s: jax.random.normal(k, shape, f32) * s
    inp = {}
    inp['x'] = nrm(ks[0], (BATCH, SEQ, D), 1.0)
    inp['ln1_g'] = 1.0 + nrm(ks[1], (L, D), 0.02)
    inp['w_in'] = nrm(ks[2], (L, D, IN_WIDTH), D ** -0.5)
    inp['b_gate'] = nrm(ks[3], (L, GATE_WIDTH), 0.02)
    inp['s5_lambda_re'] = -0.5 + nrm(ks[4], (L, G, P), 0.01)
    inp['s5_lambda_im'] = jnp.pi * jnp.arange(P, dtype=f32) + nrm(ks[5], (L, G, P), 0.01)
    inp['s5_log_step'] = jax.random.uniform(ks[6], (L, G), f32, math.log(1e-3), math.log(1e-1))
    inp['s5_b_re'] = nrm(ks[7], (L, G, P, C), (2 * C) ** -0.5)
    inp['s5_b_im'] = nrm(ks[8], (L, G, P, C), (2 * C) ** -0.5)
    inp['s5_c_re'] = nrm(ks[9], (L, G, C, P), P ** -0.5)
    inp['s5_c_im'] = nrm(ks[10], (L, G, C, P), P ** -0.5)
    inp['s5_d'] = nrm(ks[11], (L, G, C), 1.0)
    inp['s5_w_glu'] = nrm(ks[12], (L, S5_WIDTH, 2 * S5_WIDTH), S5_WIDTH ** -0.5)
    inp['w_s5_branch'] = nrm(ks[13], (L, S5_WIDTH, D), S5_WIDTH ** -0.5)
    inp['q_norm_g'] = 1.0 + nrm(ks[14], (L, HEAD_DIM), 0.02)
    inp['k_norm_g'] = 1.0 + nrm(ks[15], (L, HEAD_DIM), 0.02)
    inp['rel_bias_table'] = nrm(ks[16], (N_BUCKETS, N_Q_HEADS), 0.1)
    inp['attn_sinks'] = nrm(ks[17], (L, N_Q_HEADS), 0.5)
    inp['w_attn_branch'] = nrm(ks[18], (L, Q_WIDTH, D), Q_WIDTH ** -0.5)
    inp['w_out'] = nrm(ks[19], (L, D, D), D ** -0.5)
    inp['ln2_g'] = 1.0 + nrm(ks[20], (L, D), 0.02)
    inp['peer_w_query'] = nrm(ks[21], (L, D, PEER_HEADS * PEER_KEY_DIM), D ** -0.5)
    inp['peer_sub_keys'] = nrm(ks[22], (L, PEER_HEADS, 2, N_SUB_KEYS, PEER_KEY_DIM // 2), (PEER_KEY_DIM // 2) ** -0.5)
    inp['peer_u'] = nrm(ks[23], (L, N_EXPERTS, D), D ** -0.5)
    inp['peer_v'] = nrm(ks[24], (L, N_EXPERTS, D), D ** -0.5)
    return inp


def reference(x, ln1_g, w_in, b_gate, s5_lambda_re, s5_lambda_im, s5_log_step,
              s5_b_re, s5_b_im, s5_c_re, s5_c_im, s5_d, s5_w_glu, w_s5_branch,
              q_norm_g, k_norm_g, rel_bias_table, attn_sinks, w_attn_branch, w_out,
              ln2_g, peer_w_query, peer_sub_keys, peer_u, peer_v):
    splits = [S5_WIDTH, S5_WIDTH + Q_WIDTH, S5_WIDTH + Q_WIDTH + KV_WIDTH,
              S5_WIDTH + Q_WIDTH + 2 * KV_WIDTH]
    h = x
    for layer in range(DEPTH):
        xn = rms_norm(h, ln1_g[layer])
        proj = xn @ w_in[layer]
        u_s5, q, k, v, gate_logits = jnp.split(proj, splits, axis=-1)
        gates = jax.nn.sigmoid(gate_logits + b_gate[layer])
        g_s5, g_attn = jnp.split(gates, 2, axis=-1)
        y_s5 = s5_mixer(u_s5, s5_lambda_re[layer], s5_lambda_im[layer], s5_log_step[layer],
                        s5_b_re[layer], s5_b_im[layer], s5_c_re[layer], s5_c_im[layer],
                        s5_d[layer], s5_w_glu[layer]) @ w_s5_branch[layer]
        y_attn = sliding_window_attention(q, k, v, q_norm_g[layer], k_norm_g[layer],
                                          rel_bias_table, attn_sinks[layer]) @ w_attn_branch[layer]
        h = h + (g_s5 * y_s5 + g_attn * y_attn) @ w_out[layer]
        xn2 = rms_norm(h, ln2_g[layer])
        h = h + peer_mixer(xn2, peer_w_query[layer], peer_sub_keys[layer],
                           peer_u[layer], peer_v[layer])
    return h
```

```cpp
#include <hip/hip_runtime.h>
#include <cstdio>
#include <cstdint>
#include <cmath>

typedef unsigned short bf16;
constexpr int D = 1024, BATCH = 8, SEQ = 2048, T = BATCH * SEQ;
constexpr int S5W = 512, S5C = 16, S5NG = 32, S5P = 64;
constexpr int NQH = 16, NKV = 4, HD = 64, WIN = 128, NBUCK = 32;
constexpr int QW = 1024, KVW = 256, GATEW = 2048, INW = 4096;
constexpr int PH = 8, NSUB = 128, NEXP = 16384, TOPK = 16;
constexpr float RMS_EPS = 1e-6f;

__device__ __forceinline__ unsigned f2bf(float f) { unsigned u = __builtin_bit_cast(unsigned, f); return (u + 0x7fffu + ((u >> 16) & 1u)) >> 16; }
__device__ __forceinline__ float bf2f(unsigned h) { return __builtin_bit_cast(float, h << 16); }
__device__ __forceinline__ float wave_sum(float v) {
#pragma unroll
    for (int o = 1; o < 64; o <<= 1) v += __shfl_xor(v, o);
    return v;
}
__device__ __forceinline__ float wave_max(float v) {
#pragma unroll
    for (int o = 1; o < 64; o <<= 1) v = fmaxf(v, __shfl_xor(v, o));
    return v;
}
__device__ __forceinline__ float gelu_erf(float x) { return 0.5f * x * (1.0f + erff(x * 0.70710678118654752f)); }
__device__ __forceinline__ float sigmoidf_(float x) { return 1.0f / (1.0f + __expf(-x)); }

constexpr size_t MiB = 1u << 20;
constexpr size_t WS_R1 = 99 * MiB;
constexpr size_t WS_U5 = 131 * MiB;
constexpr size_t WS_Q = 147 * MiB;
constexpr size_t WS_K = 179 * MiB;
constexpr size_t WS_V = 187 * MiB;
constexpr size_t WS_S5G = 131 * MiB;
constexpr size_t WS_MIX = 147 * MiB;
constexpr size_t WS_QP = 147 * MiB;
constexpr size_t WS_EXP = 131 * MiB;
constexpr size_t WS_GATE = 139 * MiB;
constexpr size_t WS_YS5 = 195 * MiB;
constexpr size_t WS_END = 211 * MiB;

namespace pg8 {
#define PG8_LAS __attribute__((address_space(3)))
typedef unsigned short bf16_t;
typedef short bf16x8 __attribute__((ext_vector_type(8)));
typedef float f32x4 __attribute__((ext_vector_type(4)));
typedef unsigned u32x4 __attribute__((ext_vector_type(4)));
constexpr int BM = 256, BK = 64, HALF = 128, HTB = HALF * BK * 2  , STAGE_BYTES = 8 * HTB, NXCD = 8, WGM = 8;

__host__ __device__ __forceinline__ int lds_byte(int r, int c) { const int st = (r >> 4) * 2 + (c >> 5), rr = r & 15, cc = c & 31, ob = rr * 64 + cc * 2; return st * 1024 + (ob ^ (((ob >> 9) & 1) << 5)); }
__host__ __device__ __forceinline__ void stage_rc(int b, int& R, int& C) { const int st = b / 1024, sb = b % 1024, swz = sb ^ (((sb >> 9) & 1) << 5); R = (st >> 1) * 16 + swz / 64; C = (st & 1) * 32 + (swz % 64) / 2; }
__host__ __device__ __forceinline__ int perm32(int rho) { const int n = rho >> 4, i = rho & 15; return 8 * (i >> 2) + 4 * n + (i & 3); }

struct Unit { int pm, pn; };
struct Gemm { const bf16_t* A; const bf16_t* Bt; int M, N, K; const bf16_t* A2 = nullptr; int K1 = 0; };

struct StaticOrder {
    int nM, nN, nwg, G, c;
    __host__ __device__ void init(int M, int N, int G_, int c_) { nM = M / BM; nN = N / BM; nwg = nM * nN; G = G_; c = c_; }
    __host__ __device__ bool next(int i, Unit& u) const {
        const long L = (long)i * G + c; if (L >= nwg) return false;
        int wgid = (int)L; { const int q = nwg / NXCD, r = nwg % NXCD, xcd = wgid % NXCD, off = wgid / NXCD; wgid = (xcd < r ? xcd * (q + 1) : r * (q + 1) + (xcd - r) * q) + off; }
        const int nig = WGM * nN, gid = wgid / nig, fm = gid * WGM, gsz = (nM - fm) < WGM ? (nM - fm) : WGM;
        u.pm = fm + ((wgid % nig) % gsz); u.pn = (wgid % nig) / gsz; return true;
    }
    __device__ __forceinline__ void a_ready(const Unit&) const {}
    __device__ __forceinline__ void done(const Unit&) const {}
};

__device__ __forceinline__ unsigned cvt_pk_bf16(float lo, float hi) { unsigned r; asm volatile("v_cvt_pk_bf16_f32 %0, %1, %2" : "=v"(r) : "v"(lo), "v"(hi)); return r; }
__device__ __forceinline__ float bflo(unsigned w) { return __builtin_bit_cast(float, w << 16); }
__device__ __forceinline__ float bfhi(unsigned w) { return __builtin_bit_cast(float, w & 0xffff0000u); }
__device__ __forceinline__ float sigm(float x) { return __builtin_amdgcn_rcpf(1.0f + __expf(-x)); }
__device__ __forceinline__ f32x4 sigm4(f32x4 v) { return (f32x4){sigm(v[0]), sigm(v[1]), sigm(v[2]), sigm(v[3])}; }
__device__ __forceinline__ u32x4 pack8(f32x4 v0, f32x4 v1) { u32x4 w; w.x = cvt_pk_bf16(v0[0], v0[1]); w.y = cvt_pk_bf16(v0[2], v0[3]); w.z = cvt_pk_bf16(v1[0], v1[1]); w.w = cvt_pk_bf16(v1[2], v1[3]); return w; }
__device__ __forceinline__ void unpack8(u32x4 w, f32x4& v0, f32x4& v1) { v0 = (f32x4){bflo(w.x), bfhi(w.x), bflo(w.y), bfhi(w.y)}; v1 = (f32x4){bflo(w.z), bfhi(w.z), bflo(w.w), bfhi(w.w)}; }

struct EpiProj {
    static constexpr bool PERM = true, AFTER_DRAIN = false;
    bf16_t *U5, *Q, *K, *V, *G; const float* bgate;
    __device__ __forceinline__ void operator()(const f32x4 (&acc)[2][2][4][2], const Unit& u, int wr, int wc, int fr, int fq) const {
        const int pn = u.pn; bf16_t* base; int ldc, colt; const bool gate = pn >= 8;
        if (pn < 2) { base = U5; ldc = 512; colt = pn * 256; }
        else if (pn < 6) { base = Q; ldc = 1024; colt = (pn - 2) * 256; }
        else if (pn == 6) { base = K; ldc = 256; colt = 0; }
        else if (pn == 7) { base = V; ldc = 256; colt = 0; }
        else { base = G; ldc = 2048; colt = (pn - 8) * 256; }
        const int row0 = u.pm * BM + wr * 64 + fr, col0 = colt + wc * 32 + 8 * fq;
        f32x4 bv[2][2];
#pragma unroll
        for (int bj = 0; bj < 2; ++bj)
#pragma unroll
            for (int n = 0; n < 2; ++n) bv[bj][n] = gate ? *(const f32x4*)(bgate + col0 + bj * HALF + 4 * n) : (f32x4){0.f, 0.f, 0.f, 0.f};
#pragma unroll
        for (int ai = 0; ai < 2; ++ai)
#pragma unroll
            for (int m = 0; m < 4; ++m) { bf16_t* rowp = base + (size_t)(row0 + ai * HALF + m * 16) * ldc + col0;
#pragma unroll
                for (int bj = 0; bj < 2; ++bj) { f32x4 v0 = acc[ai][bj][m][0] + bv[bj][0], v1 = acc[ai][bj][m][1] + bv[bj][1];
                    if (gate) { v0 = sigm4(v0); v1 = sigm4(v1); }
                    if (pn < 2) {
                        const int r = row0 + ai * HALF + m * 16, cc = col0 + bj * HALF;
                        *(u32x4*)(U5 + ((size_t)((r >> 11) * 32 + (cc >> 4)) * 2048 + (r & 2047)) * 16 + (cc & 15)) = pack8(v0, v1);
                    } else *(u32x4*)(rowp + bj * HALF) = pack8(v0, v1); } }
    }
};
struct EpiGlu {
    static constexpr bool PERM = true, AFTER_DRAIN = false;
    bf16_t* O;
    __device__ __forceinline__ void operator()(const f32x4 (&acc)[2][2][4][2], const Unit& u, int wr, int wc, int fr, int fq) const {
        const int row0 = u.pm * BM + wr * 64 + fr, col0 = u.pn * 128 + wc * 32 + 8 * fq;
#pragma unroll
        for (int ai = 0; ai < 2; ++ai)
#pragma unroll
            for (int m = 0; m < 4; ++m) { bf16_t* rowp = O + (size_t)(row0 + ai * HALF + m * 16) * 512 + col0;
                const f32x4 v0 = acc[ai][0][m][0] * sigm4(acc[ai][1][m][0]), v1 = acc[ai][0][m][1] * sigm4(acc[ai][1][m][1]);
                *(u32x4*)rowp = pack8(v0, v1); }
    }
};
template <int MODE> struct EpiGate {
    static constexpr bool PERM = true, AFTER_DRAIN = false;
    bf16_t* O; int ldc; const bf16_t* G; int goff;
    __device__ __forceinline__ void operator()(const f32x4 (&acc)[2][2][4][2], const Unit& u, int wr, int wc, int fr, int fq) const {
        const int row0 = u.pm * BM + wr * 64 + fr, col0 = u.pn * BM + wc * 32 + 8 * fq;
#pragma unroll
        for (int ai = 0; ai < 2; ++ai)
#pragma unroll
            for (int m = 0; m < 4; ++m) { const size_t row = (size_t)(row0 + ai * HALF + m * 16); bf16_t* rowp = O + row * ldc + col0;
#pragma unroll
                for (int bj = 0; bj < 2; ++bj) { f32x4 v0 = acc[ai][bj][m][0], v1 = acc[ai][bj][m][1];
                    if (MODE >= 1) { f32x4 g0, g1; unpack8(*(const u32x4*)(G + row * 2048 + goff + col0 + bj * HALF), g0, g1); v0 = v0 * g0; v1 = v1 * g1; }
                    if (MODE == 2) { f32x4 t0, t1; unpack8(*(const u32x4*)(rowp + bj * HALF), t0, t1); v0 = v0 + t0; v1 = v1 + t1; }
                    *(u32x4*)(rowp + bj * HALF) = pack8(v0, v1); } }
    }
};
struct EpiGateDual {
    static constexpr bool PERM = true, AFTER_DRAIN = false;
    bf16_t* O; int ldc; const bf16_t* G;
    static __device__ __forceinline__ f32x4 lowc(f32x4 g) { return (f32x4){fmaxf(g[0], 0x1p-60f), fmaxf(g[1], 0x1p-60f), fmaxf(g[2], 0x1p-60f), fmaxf(g[3], 0x1p-60f)}; }
    static __device__ __forceinline__ f32x4 rcp4(f32x4 g) { return (f32x4){__builtin_amdgcn_rcpf(g[0]), __builtin_amdgcn_rcpf(g[1]), __builtin_amdgcn_rcpf(g[2]), __builtin_amdgcn_rcpf(g[3])}; }
    __device__ __forceinline__ void mid(f32x4 (&acc)[2][2][4][2], const Unit& u, int wr, int wc, int fr, int fq) const {
        const int row0 = u.pm * BM + wr * 64 + fr, col0 = u.pn * BM + wc * 32 + 8 * fq;
#pragma unroll
        for (int ai = 0; ai < 2; ++ai)
#pragma unroll
            for (int m = 0; m < 4; ++m) { const size_t row = (size_t)(row0 + ai * HALF + m * 16);
#pragma unroll
                for (int bj = 0; bj < 2; ++bj) { f32x4 a0, a1, b0, b1;
                    unpack8(*(const u32x4*)(G + row * 2048 + col0 + bj * HALF), a0, a1); unpack8(*(const u32x4*)(G + row * 2048 + 1024 + col0 + bj * HALF), b0, b1);
                    acc[ai][bj][m][0] = acc[ai][bj][m][0] * (a0 * rcp4(lowc(b0))); acc[ai][bj][m][1] = acc[ai][bj][m][1] * (a1 * rcp4(lowc(b1))); } }
    }
    __device__ __forceinline__ void operator()(const f32x4 (&acc)[2][2][4][2], const Unit& u, int wr, int wc, int fr, int fq) const {
        const int row0 = u.pm * BM + wr * 64 + fr, col0 = u.pn * BM + wc * 32 + 8 * fq;
#pragma unroll
        for (int ai = 0; ai < 2; ++ai)
#pragma unroll
            for (int m = 0; m < 4; ++m) { const size_t row = (size_t)(row0 + ai * HALF + m * 16); bf16_t* rowp = O + row * ldc + col0;
#pragma unroll
                for (int bj = 0; bj < 2; ++bj) { f32x4 b0, b1; unpack8(*(const u32x4*)(G + row * 2048 + 1024 + col0 + bj * HALF), b0, b1);
                    *(u32x4*)(rowp + bj * HALF) = pack8(acc[ai][bj][m][0] * lowc(b0), acc[ai][bj][m][1] * lowc(b1)); } }
    }
};
struct EpiRes {
    static constexpr bool PERM = true, AFTER_DRAIN = false;
    const float* base; float* out; bf16_t* hb; float* ssq;
    __device__ __forceinline__ void operator()(const f32x4 (&acc)[2][2][4][2], const Unit& u, int wr, int wc, int fr, int fq) const {
        const int row0 = u.pm * BM + wr * 64 + fr, col0 = u.pn * BM + wc * 32 + 8 * fq;
#pragma unroll
        for (int ai = 0; ai < 2; ++ai)
#pragma unroll
            for (int m = 0; m < 4; ++m) { const size_t row = (size_t)(row0 + ai * HALF + m * 16), off = row * 1024 + col0; float ss = 0.f;
#pragma unroll
                for (int bj = 0; bj < 2; ++bj) {
                    const f32x4 b0 = __builtin_nontemporal_load((const f32x4*)(base + off + bj * HALF)), b1 = __builtin_nontemporal_load((const f32x4*)(base + off + bj * HALF + 4));
                    const f32x4 h0 = b0 + acc[ai][bj][m][0], h1 = b1 + acc[ai][bj][m][1];
                    *(u32x4*)(hb + off + bj * HALF) = pack8(h0, h1);
                    ss += (h0[0] * h0[0] + h0[1] * h0[1]) + (h0[2] * h0[2] + h0[3] * h0[3]) + (h1[0] * h1[0] + h1[1] * h1[1]) + (h1[2] * h1[2] + h1[3] * h1[3]); }
                ss += __shfl_xor(ss, 16); ss += __shfl_xor(ss, 32);
                if (fq == 0) ssq[row * 16 + u.pn * 4 + wc] = ss; }
    }
};
struct EpiRowScale {
    static constexpr bool PERM = true, AFTER_DRAIN = false;
    bf16_t* O; int ldc; const PG8_LAS float* rrow;
    __device__ __forceinline__ void operator()(const f32x4 (&acc)[2][2][4][2], const Unit& u, int wr, int wc, int fr, int fq) const {
        const int row0 = u.pm * BM + wr * 64 + fr, col0 = u.pn * BM + wc * 32 + 8 * fq;
#pragma unroll
        for (int ai = 0; ai < 2; ++ai)
#pragma unroll
            for (int m = 0; m < 4; ++m) { const int rl = wr * 64 + fr + ai * HALF + m * 16; const float r = rrow[rl]; bf16_t* rowp = O + (size_t)(u.pm * BM + rl) * ldc + col0;
#pragma unroll
                for (int bj = 0; bj < 2; ++bj) *(u32x4*)(rowp + bj * HALF) = pack8(acc[ai][bj][m][0] * r, acc[ai][bj][m][1] * r); }
    }
};
template <class Epi, class Sched, bool ALIGN_EPI = false, bool SP2 = false, bool DUAL = false>
__device__ __forceinline__ void gemm_phase(PG8_LAS unsigned char* lds, const Gemm g, const Sched& S, const Epi& E) {
    const int tid = threadIdx.x, wid = __builtin_amdgcn_readfirstlane(tid >> 6), lane = tid & 63, wr = wid >> 2, wc = wid & 3, fr = lane & 15, fq = lane >> 4;
    static_assert(!DUAL || SP2, "DUAL is written for the SP2 loop");
    const int K = g.K, nt = K / BK, KA = DUAL ? g.K1 : K, KA2 = K - KA, nt1 = KA / BK;
    unsigned voffA[2], voffB[2], voffA2[2];
#pragma unroll
    for (int i = 0; i < 2; ++i) { int R, C; stage_rc(tid * 16 + i * 8192, R, C); const int Rb = Epi::PERM ? ((R & ~31) + perm32(R & 31)) : R;
        voffA[i] = (unsigned)(R * KA + C) * 2u; voffB[i] = (unsigned)(Rb * K + C) * 2u; voffA2[i] = (unsigned)(R * KA2 + C) * 2u; }
    const size_t kstep = (size_t)(BK * 2);
    const size_t hstep = (size_t)HALF * K * 2;
    const size_t tstep = 2 * hstep;
    const size_t hstepA = (size_t)HALF * KA * 2, hstepA2 = (size_t)HALF * KA2 * 2;
    const unsigned ldsw = (unsigned)wid * 1024u;
    const int aoff = lds_byte(wr * 64 + fr, fq * 8), boff = lds_byte(wc * 32 + fr, fq * 8);
#define PG8_SA(b, h) (((b) * 2 + (h)) * HTB)
#define PG8_SB(b, h) ((4 + (b) * 2 + (h)) * HTB)
#define PG8_STAGE(bufoff, gbase, voff) do { _Pragma("unroll") for (int _i = 0; _i < 2; ++_i) \
        __builtin_amdgcn_global_load_lds((const unsigned*)((const char*)(gbase) + (voff)[_i]), (PG8_LAS unsigned*)(lds + (bufoff) + ldsw + _i * 8192), 16, 0, 0); } while (0)
#define PG8_STA(bufoff, optr, tt, h) do { if constexpr (DUAL) { const int _tt = (tt); const bool _s2 = _tt >= nt1; \
        const char* _p = _s2 ? cA2 + (size_t)(_tt - nt1) * kstep + (size_t)(h) * hstepA2 : cA + (size_t)_tt * kstep + (size_t)(h) * hstepA; \
        const unsigned _v[2] = {_s2 ? voffA2[0] : voffA[0], _s2 ? voffA2[1] : voffA[1]}; PG8_STAGE(bufoff, _p, _v); } else { PG8_STAGE(bufoff, optr, voffA); } } while (0)
#define PG8_LDA(dst, b, h) do { _Pragma("unroll") for (int m = 0; m < 4; ++m) _Pragma("unroll") for (int k = 0; k < 2; ++k) dst[m][k] = *(const PG8_LAS bf16x8*)(lds + PG8_SA(b, h) + aoff + m * 2048 + k * 1024); } while (0)
#define PG8_LDB(dst, b, h) do { _Pragma("unroll") for (int n = 0; n < 2; ++n) _Pragma("unroll") for (int k = 0; k < 2; ++k) dst[n][k] = *(const PG8_LAS bf16x8*)(lds + PG8_SB(b, h) + boff + n * 2048 + k * 1024); } while (0)
#define PG8_MMA(ai, bj, At, Bt) do { __builtin_amdgcn_s_setprio(1); _Pragma("unroll") for (int m = 0; m < 4; ++m) _Pragma("unroll") for (int n = 0; n < 2; ++n) _Pragma("unroll") for (int k = 0; k < 2; ++k) \
        acc[ai][bj][m][n] = __builtin_amdgcn_mfma_f32_16x16x32_bf16(Bt[n][k], At[m][k], acc[ai][bj][m][n], 0, 0, 0); __builtin_amdgcn_s_setprio(0); } while (0)
#define PG8_WAIT_V(n) asm volatile("s_waitcnt vmcnt(" #n ")" ::: "memory")
#define PG8_WAIT_L(n) asm volatile("s_waitcnt lgkmcnt(" #n ")" ::: "memory")
#define PG8_BAR __builtin_amdgcn_s_barrier()
#define PG8_SCHED __builtin_amdgcn_sched_barrier(0)
    Unit cur, nxt; int ui = 0;
    if (!S.next(0, cur)) return;
    f32x4 acc[2][2][4][2];
#pragma unroll
    for (int a = 0; a < 2; ++a)
#pragma unroll
        for (int b = 0; b < 2; ++b)
#pragma unroll
            for (int m = 0; m < 4; ++m)
#pragma unroll
                for (int n = 0; n < 2; ++n) acc[a][b][m][n] = (f32x4){0.f, 0.f, 0.f, 0.f};
    bf16x8 At[4][2], B0[2][2], B1[2][2];
    const char* cA = (const char*)g.A + (size_t)cur.pm * (DUAL ? 2 * hstepA : tstep); const char* cB = (const char*)g.Bt + (size_t)cur.pn * tstep;
    const char* cA2 = DUAL ? (const char*)g.A2 + (size_t)cur.pm * 2 * hstepA2 : cA;
    S.a_ready(cur);
    if constexpr (SP2) {
        PG8_STAGE(PG8_SB(0, 0), cB, voffB); PG8_STAGE(PG8_SB(0, 1), cB + hstep, voffB); PG8_STA(PG8_SA(0, 0), cA, 0, 0); PG8_STA(PG8_SA(0, 1), cA + hstep, 0, 1);
        if (wr == 1) PG8_BAR;
        PG8_WAIT_V(2); PG8_BAR;
        PG8_STAGE(PG8_SB(1, 0), cB + kstep, voffB); PG8_STA(PG8_SA(1, 0), cA + kstep, 1, 0); PG8_STAGE(PG8_SB(1, 1), cB + hstep + kstep, voffB);
        PG8_WAIT_V(6); PG8_BAR;
    } else {
        PG8_STAGE(PG8_SB(0, 0), cB, voffB); PG8_STAGE(PG8_SA(0, 0), cA, voffA); PG8_STAGE(PG8_SB(0, 1), cB + hstep, voffB); PG8_STAGE(PG8_SA(0, 1), cA + hstep, voffA);
        if (wr == 1) PG8_BAR;
        PG8_WAIT_V(4); PG8_BAR;
        PG8_STAGE(PG8_SB(1, 0), cB + kstep, voffB); PG8_STAGE(PG8_SA(1, 0), cA + kstep, voffA); PG8_STAGE(PG8_SB(1, 1), cB + hstep + kstep, voffB);
        PG8_WAIT_V(6); PG8_BAR;
    }
    for (;;) {
        const bool has_next = S.next(ui + 1, nxt);
        const char* nA = has_next ? (const char*)g.A + (size_t)nxt.pm * tstep : cA; const char* nB = has_next ? (const char*)g.Bt + (size_t)nxt.pn * tstep : cB;
        for (int t = 0; t < nt; t += 2) {
            const bool last = (t == nt - 2);
            const char* a1 = cA + (size_t)(t + 1) * kstep;
            const char* a2 = last ? nA : cA + (size_t)(t + 2) * kstep; const char* b2 = last ? nB : cB + (size_t)(t + 2) * kstep;
            const char* a3 = a2 + kstep; const char* b3 = b2 + kstep;
            if (last && has_next) S.a_ready(nxt);
            const int tt2 = last ? 0 : t + 2, tt3 = tt2 + 1;
            if constexpr (DUAL) { if (t == nt1) E.mid(acc, cur, wr, wc, fr, fq); }
            if constexpr (SP2) {
            PG8_LDB(B0, 0, 0); PG8_LDB(B1, 0, 1); PG8_SCHED; PG8_LDA(At, 0, 0); PG8_STA(PG8_SA(1, 1), a1 + hstep, t + 1, 1);
            PG8_WAIT_V(8); PG8_WAIT_L(0); PG8_BAR; PG8_MMA(0, 0, At, B0); PG8_MMA(0, 1, At, B1); PG8_BAR; PG8_SCHED;
            PG8_LDA(At, 0, 1); PG8_STAGE(PG8_SB(0, 0), b2, voffB); PG8_STAGE(PG8_SB(0, 1), b2 + hstep, voffB); PG8_STA(PG8_SA(0, 0), a2, tt2, 0);
            PG8_WAIT_V(8); PG8_WAIT_L(0); PG8_BAR; PG8_MMA(1, 0, At, B0); PG8_MMA(1, 1, At, B1); PG8_BAR; PG8_SCHED;
            PG8_LDB(B0, 1, 0); PG8_LDB(B1, 1, 1); PG8_SCHED; PG8_LDA(At, 1, 0); PG8_STA(PG8_SA(0, 1), a2 + hstep, tt2, 1);
            PG8_WAIT_V(8); PG8_WAIT_L(0); PG8_BAR; PG8_MMA(0, 0, At, B0); PG8_MMA(0, 1, At, B1); PG8_BAR; PG8_SCHED;
            PG8_LDA(At, 1, 1); PG8_STAGE(PG8_SB(1, 0), b3, voffB); PG8_STAGE(PG8_SB(1, 1), b3 + hstep, voffB); PG8_STA(PG8_SA(1, 0), a3, tt3, 0);
            PG8_WAIT_V(8); PG8_WAIT_L(0); PG8_BAR; PG8_MMA(1, 0, At, B0); PG8_MMA(1, 1, At, B1); PG8_BAR; PG8_SCHED;
            } else {
            PG8_LDB(B0, 0, 0); PG8_SCHED; PG8_LDA(At, 0, 0); PG8_STAGE(PG8_SA(1, 1), a1 + hstep, voffA);
            PG8_WAIT_L(8); PG8_BAR; PG8_WAIT_L(0); PG8_MMA(0, 0, At, B0); PG8_BAR; PG8_SCHED;
            PG8_LDB(B1, 0, 1); PG8_STAGE(PG8_SB(0, 0), b2, voffB);
            PG8_BAR; PG8_WAIT_L(0); PG8_MMA(0, 1, At, B1); PG8_BAR;
            PG8_LDA(At, 0, 1); PG8_STAGE(PG8_SA(0, 0), a2, voffA);
            PG8_BAR; PG8_WAIT_L(0); PG8_MMA(1, 0, At, B0); PG8_BAR; PG8_SCHED;
            PG8_STAGE(PG8_SB(0, 1), b2 + hstep, voffB);
            PG8_WAIT_V(6); PG8_BAR; PG8_MMA(1, 1, At, B1); PG8_BAR;
            PG8_LDB(B0, 1, 0); PG8_SCHED; PG8_LDA(At, 1, 0); PG8_STAGE(PG8_SA(0, 1), a2 + hstep, voffA);
            PG8_WAIT_L(8); PG8_BAR; PG8_WAIT_L(0); PG8_MMA(0, 0, At, B0); PG8_BAR; PG8_SCHED;
            PG8_LDB(B1, 1, 1); PG8_STAGE(PG8_SB(1, 0), b3, voffB);
            PG8_BAR; PG8_WAIT_L(0); PG8_MMA(0, 1, At, B1); PG8_BAR;
            PG8_LDA(At, 1, 1); PG8_STAGE(PG8_SA(1, 0), a3, voffA);
            PG8_BAR; PG8_WAIT_L(0); PG8_MMA(1, 0, At, B0); PG8_BAR; PG8_SCHED;
            PG8_STAGE(PG8_SB(1, 1), b3 + hstep, voffB);
            PG8_WAIT_V(6); PG8_BAR; PG8_MMA(1, 1, At, B1); PG8_BAR;
            }
        }
        if constexpr (ALIGN_EPI) { if (wr == 0) PG8_BAR; }
        if constexpr (!Epi::AFTER_DRAIN) { E(acc, cur, wr, wc, fr, fq); S.done(cur); }
        if (!has_next) break;
#pragma unroll
        for (int a = 0; a < 2; ++a)
#pragma unroll
            for (int b = 0; b < 2; ++b)
#pragma unroll
                for (int m = 0; m < 4; ++m)
#pragma unroll
                    for (int n = 0; n < 2; ++n) acc[a][b][m][n] = (f32x4){0.f, 0.f, 0.f, 0.f};
        cur = nxt; cA = nA; cB = nB; ++ui;
        if constexpr (ALIGN_EPI) { if (wr == 1) PG8_BAR; }
    }
    PG8_WAIT_V(0);
    if constexpr (!ALIGN_EPI) { if (wr == 0) PG8_BAR; }
    PG8_BAR;
    if constexpr (Epi::AFTER_DRAIN) { E.fused(acc, cur, wr, wc, fr, fq, lds, wid, lane); S.done(cur); }
#undef PG8_SA
#undef PG8_SB
#undef PG8_STAGE
#undef PG8_STA
#undef PG8_LDA
#undef PG8_LDB
#undef PG8_MMA
#undef PG8_WAIT_V
#undef PG8_WAIT_L
#undef PG8_BAR
#undef PG8_SCHED
}
}
constexpr int NWAVES = 8;
constexpr size_t WS_CTL = 0, CTL_ZERO_BYTES = 64 * 1024;
constexpr size_t WS_A64 = 512 * 1024;
constexpr size_t WS_W1T = 1 * MiB;
constexpr size_t WS_WGLUT = 9 * MiB;
constexpr size_t WS_WS5T = 10 * MiB;
constexpr size_t WS_WATT = 11 * MiB;
constexpr size_t WS_WOUT = 13 * MiB;
constexpr size_t WS_WQT = 15 * MiB;
constexpr size_t WS_SKB = 17 * MiB;
constexpr size_t WS_UB = 18 * MiB;
constexpr size_t WS_VB = 50 * MiB;
constexpr size_t WS_KT = 82 * MiB;
constexpr size_t WS_E = 83 * MiB;
constexpr size_t WS_F = 91 * MiB;
static_assert(WS_F + 8 * MiB <= WS_R1, "ws map");
constexpr size_t WS_RROW = 768 * 1024;
constexpr size_t WS_SSQ = 58 * MiB;
constexpr int CW_BAR = 1024;

constexpr int RING_BYTES = 131072;
constexpr int LDSCTL_OFF = 142336, MISC_OFF = LDSCTL_OFF + 320, RROW_OFF = LDSCTL_OFF + 1024;
constexpr int LDS_BYTES = 147456;
#define GAS __attribute__((address_space(1)))
#define LAS __attribute__((address_space(3)))
typedef unsigned v4u __attribute__((ext_vector_type(4)));
typedef unsigned v2u __attribute__((ext_vector_type(2)));
typedef float f32x4 __attribute__((ext_vector_type(4)));
typedef float f32x16 __attribute__((ext_vector_type(16)));
typedef short bf16x8 __attribute__((ext_vector_type(8)));
typedef GAS unsigned gu32;
#define RLX_AGENT __ATOMIC_RELAXED, __HIP_MEMORY_SCOPE_AGENT
#define LDS_WAIT() asm volatile("s_waitcnt lgkmcnt(0)" ::: "memory")
#define VM_WAIT() asm volatile("s_waitcnt vmcnt(0)" ::: "memory")
__device__ __forceinline__ unsigned pk2(float lo, float hi) { return f2bf(lo) | (f2bf(hi) << 16); }
__device__ __forceinline__ unsigned cvtpk(float lo, float hi) { unsigned r; asm volatile("v_cvt_pk_bf16_f32 %0, %1, %2" : "=v"(r) : "v"(lo), "v"(hi)); return r; }
__device__ __forceinline__ float blo(unsigned w) { return __builtin_bit_cast(float, w << 16); }
__device__ __forceinline__ float bhi(unsigned w) { return __builtin_bit_cast(float, w & 0xffff0000u); }
#define XB_TMO      128
#define XB_XCNT(j)  (256  + 64 * (j))
#define XB_XSUB(j)  (1280 + 64 * (j))
#define XB_XGEN(j)  (2304 + 64 * (j))
#define XB_TOP      3328
#define XB_TOPGEN   3392
#define XCD_BAR_WORDS 3456
#define XB_SPIN_CAP (1u << 18)

__device__ __forceinline__ unsigned xb_ld(unsigned* p)              { return __hip_atomic_load(p, __ATOMIC_RELAXED, __HIP_MEMORY_SCOPE_AGENT); }
__device__ __forceinline__ unsigned xb_add(unsigned* p, unsigned v) { return __hip_atomic_fetch_add(p, v, __ATOMIC_RELAXED, __HIP_MEMORY_SCOPE_AGENT); }
__device__ __forceinline__ unsigned xb_xcc_id() { return (unsigned)__builtin_amdgcn_s_getreg((3 << 11) | 20) & 0xFu; }
#define XB_SPIN(cond, bar) do { unsigned _sp = 0; while (cond) { __builtin_amdgcn_s_sleep(1); \
    if ((++_sp & 255u) == 0u) { if (xb_ld(&(bar)[XB_TMO])) break; if (_sp > XB_SPIN_CAP) { atomicAdd(&(bar)[XB_TMO], 1u); break; } } } } while (0)

struct XcdBarrier {
    unsigned* bar; unsigned x;
    volatile LAS unsigned* st;
};

__device__ __forceinline__ XcdBarrier xcd_barrier_post(unsigned* bar, volatile LAS unsigned* st) {
    XcdBarrier b; b.bar = bar; b.x = xb_xcc_id(); b.st = st;
    if (threadIdx.x == 0) (void)xb_add(&bar[XB_XCNT(b.x)], 1u);
    return b;
}
__device__ __forceinline__ void xcd_barrier_complete(unsigned* bar, unsigned x, unsigned& nloc, unsigned& nx) {
    const unsigned G = gridDim.x * gridDim.y * gridDim.z;
    unsigned sum, cnt, mine, sp = 0u;
    for (;;) {
        sum = 0u; cnt = 0u; mine = 0u;
#pragma unroll
        for (unsigned j = 0; j < 16; ++j) { const unsigned c = xb_ld(&bar[XB_XCNT(j)]); sum += c; cnt += (c > 0u) ? 1u : 0u; mine = (j == x) ? c : mine; }
        if (sum == G) break;
        __builtin_amdgcn_s_sleep(1);
        if ((++sp & 255u) == 0u) { if (xb_ld(&bar[XB_TMO])) break; if (sp > XB_SPIN_CAP) { atomicAdd(&bar[XB_TMO], 1u); break; } }
    }
    nloc = mine > 0u ? mine : 1u; nx = cnt > 0u ? cnt : 1u;
}

__device__ __forceinline__ void xcd_barrier(const XcdBarrier& b) {
    asm volatile("s_waitcnt vmcnt(0)" ::: "memory");
    __syncthreads();
    if (threadIdx.x == 0) {
        unsigned* bar = b.bar;
        __builtin_amdgcn_s_waitcnt(0);
        unsigned nloc = b.st[0], nx = b.st[1];
        if (nloc == 0u) { xcd_barrier_complete(bar, b.x, nloc, nx); b.st[0] = nloc; b.st[1] = nx; }
        const unsigned old = xb_add(&bar[XB_XSUB(b.x)], 1u);
        const unsigned gen = old / nloc;
        if (old + 1u == (gen + 1u) * nloc) {
            __builtin_amdgcn_fence(__ATOMIC_RELEASE, "agent");
            asm volatile("s_waitcnt vmcnt(0)" ::: "memory");
            const unsigned og = xb_add(&bar[XB_TOP], 1u);
            const unsigned tg = og / nx;
            if (og + 1u == (tg + 1u) * nx) xb_add(&bar[XB_TOPGEN], 1u);
            else XB_SPIN(xb_ld(&bar[XB_TOPGEN]) == tg, bar);
            __builtin_amdgcn_fence(__ATOMIC_ACQUIRE, "agent");
            xb_add(&bar[XB_XGEN(b.x)], 1u);
            asm volatile("s_waitcnt vmcnt(0)" ::: "memory");
        } else {
            XB_SPIN(xb_ld(&bar[XB_XGEN(b.x)]) == gen, bar);
            __builtin_amdgcn_fence(__ATOMIC_ACQUIRE, "agent");
            asm volatile("s_waitcnt vmcnt(0)" ::: "memory");
        }
    }
    __syncthreads();
}
struct Frame {
    LAS unsigned char* lds;
    volatile LAS unsigned* MISC;
    gu32* ctl;
    int tid, lane, wave, vcu, G;
    const float* in[25]; float* out; unsigned char* ws;
};
enum { I_X = 0, I_LN1, I_WIN, I_BGATE, I_LRE, I_LIM, I_LSTEP, I_BRE, I_BIM, I_CRE, I_CIM, I_S5D, I_WGLU, I_WS5B, I_GQ, I_GK, I_BIAS, I_SINK, I_WATT, I_WOUT, I_LN2, I_WQ, I_SK, I_PU, I_PV };

template <bool GLU>
__device__ __forceinline__ void p0_transpose_item(const float* W, int K, int N, bf16* WT, LAS float* scr, int item, int lane, const float* kscale = nullptr, int ldw = 0) {
    if (ldw == 0) ldw = K;
    const int nblk = N / 32, kb = item / nblk, nb = item % nblk, k0 = 64 * kb, n0 = 32 * nb;
#pragma unroll 8
    for (int i = 0; i < 32; ++i) { const int kk = 2 * i + (lane >> 5); const float sc_ = kscale ? kscale[k0 + kk] : 1.0f; scr[kk * 33 + (lane & 31)] = __builtin_nontemporal_load((const GAS float*)(W + (size_t)(k0 + kk) * N + n0 + (lane & 31))) * sc_; }
    LDS_WAIT(); asm volatile("" ::: "memory");
    const int c = lane & 7;
#pragma unroll
    for (int j = 0; j < 4; ++j) { const int n = (lane >> 3) + 8 * j; const LAS float* s = scr + (8 * c) * 33 + n;
        v4u o; o.x = pk2(s[0 * 33], s[1 * 33]); o.y = pk2(s[2 * 33], s[3 * 33]); o.z = pk2(s[4 * 33], s[5 * 33]); o.w = pk2(s[6 * 33], s[7 * 33]);
        const int nn = n0 + n; const int row = GLU ? (256 * ((nn & 511) >> 7) + 128 * (nn >> 9) + (nn & 127)) : nn;
        *(GAS v4u*)(WT + (size_t)row * ldw + k0 + 8 * c) = o; }
    LDS_WAIT(); asm volatile("" ::: "memory");
}
struct TrDesc { const float* W; bf16* WT; const float* kscale; int K, N, ldw, item; bool glu; };
struct TrRegs { f32x4 v[8]; };
__device__ __forceinline__ void tr_load(const TrDesc& d, TrRegs& R, int lane) {
    const int nblk = d.N / 32, kb = d.item / nblk, nb = d.item % nblk, k0 = 64 * kb, n0 = 32 * nb;
#pragma unroll
    for (int i = 0; i < 8; ++i) R.v[i] = __builtin_nontemporal_load((const GAS f32x4*)(d.W + (size_t)(k0 + 8 * i + (lane >> 3)) * d.N + n0 + 4 * (lane & 7)));
}
__device__ __forceinline__ void tr_finish(const TrDesc& d, const TrRegs& R, LAS float* scr, int lane) {
    const int nblk = d.N / 32, kb = d.item / nblk, nb = d.item % nblk, k0 = 64 * kb, n0 = 32 * nb;
#pragma unroll
    for (int i = 0; i < 8; ++i) { const int kk = 8 * i + (lane >> 3); const float sc_ = d.kscale ? d.kscale[k0 + kk] : 1.0f; LAS float* sp = scr + kk * 33 + 4 * (lane & 7);
        sp[0] = R.v[i][0] * sc_; sp[1] = R.v[i][1] * sc_; sp[2] = R.v[i][2] * sc_; sp[3] = R.v[i][3] * sc_; }
    LDS_WAIT(); asm volatile("" ::: "memory");
    const int c = lane & 7;
#pragma unroll
    for (int j = 0; j < 4; ++j) { const int n = (lane >> 3) + 8 * j; const LAS float* s = scr + (8 * c) * 33 + n;
        v4u o; o.x = pk2(s[0 * 33], s[1 * 33]); o.y = pk2(s[2 * 33], s[3 * 33]); o.z = pk2(s[4 * 33], s[5 * 33]); o.w = pk2(s[6 * 33], s[7 * 33]);
        const int nn = n0 + n; const int row = d.glu ? (256 * ((nn & 511) >> 7) + 128 * (nn >> 9) + (nn & 127)) : nn;
        *(GAS v4u*)(d.WT + (size_t)row * d.ldw + k0 + 8 * c) = o; }
    LDS_WAIT(); asm volatile("" ::: "memory");
}
__device__ __forceinline__ void p0_convert_row(const float* src, bf16* dst, int lane) {
#pragma unroll
    for (int j = 0; j < 2; ++j) { const int c = lane + 64 * j; const f32x4 a = *(const GAS f32x4*)(src + 8 * c), b = *(const GAS f32x4*)(src + 8 * c + 4);
        v4u o; o.x = pk2(a[0], a[1]); o.y = pk2(a[2], a[3]); o.z = pk2(b[0], b[1]); o.w = pk2(b[2], b[3]); *(GAS v4u*)(dst + 8 * c) = o; }
}
template <bool FP8>
__device__ __forceinline__ void rms_row_to_bf16(const float* xrow, const float* g, bf16* orow, int lane, unsigned char* oh = nullptr, unsigned char* ol = nullptr) {
    const GAS f32x4* xr = (const GAS f32x4*)xrow + lane;
    f32x4 v[4]; float s = 0.f;
#pragma unroll
    for (int j = 0; j < 4; ++j) { v[j] = xr[64 * j]; s += (v[j].x * v[j].x + v[j].y * v[j].y) + (v[j].z * v[j].z + v[j].w * v[j].w); }
    s = wave_sum(s);
    const float r = rsqrtf(s * (1.0f / D) + RMS_EPS);
    const GAS f32x4* gr = (const GAS f32x4*)g + lane;
    GAS v2u* o = (GAS v2u*)orow + lane;
#pragma unroll
    for (int j = 0; j < 4; ++j) { const f32x4 gg = gr[64 * j]; const f32x4 y = {v[j].x * r * gg.x, v[j].y * r * gg.y, v[j].z * r * gg.z, v[j].w * r * gg.w};
        v2u w; w.x = pk2(y.x, y.y); w.y = pk2(y.z, y.w); o[64 * j] = w;
        if (FP8) { int h = 0; h = __builtin_amdgcn_cvt_pk_fp8_f32(y.x, y.y, h, false); h = __builtin_amdgcn_cvt_pk_fp8_f32(y.z, y.w, h, true);
            const auto h01 = __builtin_amdgcn_cvt_pk_f32_fp8(h, false), h23 = __builtin_amdgcn_cvt_pk_f32_fp8(h, true);
            int l = 0; l = __builtin_amdgcn_cvt_pk_fp8_f32(y.x - h01[0], y.y - h01[1], l, false); l = __builtin_amdgcn_cvt_pk_fp8_f32(y.z - h23[0], y.w - h23[1], l, true);
            ((GAS int*)oh)[lane + 64 * j] = h; ((GAS int*)ol)[lane + 64 * j] = l; } }
}
template <int NR>
__device__ __forceinline__ void rms_rows_to_bf16(const float* x, size_t row_stride, const float* g, bf16* o, int lane) {
    f32x4 v[NR][4]; float s[NR];
#pragma unroll
    for (int r = 0; r < NR; ++r)
#pragma unroll
        for (int j = 0; j < 4; ++j) v[r][j] = __builtin_nontemporal_load((const GAS f32x4*)(x + r * row_stride) + lane + 64 * j);
#pragma unroll
    for (int r = 0; r < NR; ++r) { s[r] = 0.f;
#pragma unroll
        for (int j = 0; j < 4; ++j) s[r] += (v[r][j].x * v[r][j].x + v[r][j].y * v[r][j].y) + (v[r][j].z * v[r][j].z + v[r][j].w * v[r][j].w); }
#pragma unroll
    for (int of = 1; of < 64; of <<= 1)
#pragma unroll
        for (int r = 0; r < NR; ++r) s[r] += __shfl_xor(s[r], of);
    const GAS f32x4* gr = (const GAS f32x4*)g + lane;
#pragma unroll
    for (int j = 0; j < 4; ++j) { const f32x4 gg = gr[64 * j];
#pragma unroll
        for (int r = 0; r < NR; ++r) { const float rr = rsqrtf(s[r] * (1.0f / D) + RMS_EPS); v2u w;
            w.x = pk2(v[r][j].x * rr * gg.x, v[r][j].y * rr * gg.y); w.y = pk2(v[r][j].z * rr * gg.z, v[r][j].w * rr * gg.w); ((GAS v2u*)(o + r * row_stride) + lane)[64 * j] = w; } }
}
struct XPipe { f32x4 v[4][4]; };
__device__ __forceinline__ void x_issue(XPipe& X, const float* x, size_t row_stride, int lane) {
#pragma unroll
    for (int r = 0; r < 4; ++r)
#pragma unroll
        for (int j = 0; j < 4; ++j) X.v[r][j] = __builtin_nontemporal_load((const GAS f32x4*)(x + r * row_stride) + lane + 64 * j);
}
__device__ __forceinline__ void x_retire(const XPipe& X, size_t row_stride, const float* g, bf16* o, int lane) {
    float s[4];
#pragma unroll
    for (int r = 0; r < 4; ++r) { s[r] = 0.f;
#pragma unroll
        for (int j = 0; j < 4; ++j) s[r] += (X.v[r][j].x * X.v[r][j].x + X.v[r][j].y * X.v[r][j].y) + (X.v[r][j].z * X.v[r][j].z + X.v[r][j].w * X.v[r][j].w); }
#pragma unroll
    for (int of = 1; of < 64; of <<= 1)
#pragma unroll
        for (int r = 0; r < 4; ++r) s[r] += __shfl_xor(s[r], of);
    const GAS f32x4* gr = (const GAS f32x4*)g + lane;
#pragma unroll
    for (int j = 0; j < 4; ++j) { const f32x4 gg = gr[64 * j];
#pragma unroll
        for (int r = 0; r < 4; ++r) { const float rr = rsqrtf(s[r] * (1.0f / D) + RMS_EPS); v2u w;
            w.x = pk2(X.v[r][j].x * rr * gg.x, X.v[r][j].y * rr * gg.y); w.y = pk2(X.v[r][j].z * rr * gg.z, X.v[r][j].w * rr * gg.w); ((GAS v2u*)(o + r * row_stride) + lane)[64 * j] = w; } }
}
struct P0Row { f32x4 v[4]; };
__device__ __forceinline__ void p0_fp8_load(P0Row& R, const float* src, int lane) {
#pragma unroll
    for (int i = 0; i < 4; ++i) R.v[i] = __builtin_nontemporal_load((const GAS f32x4*)(src + 4 * (lane + 64 * i)));
}
__device__ __forceinline__ void p0_fp8_store(const P0Row& R, unsigned char* dst, int e, int lane, const float* cscale = nullptr) {
    const float S = 256.0f;
#pragma unroll
    for (int i = 0; i < 4; ++i) { f32x4 sv = {S, S, S, S}; if (cscale) sv = sv * *(const GAS f32x4*)(cscale + 4 * (lane + 64 * i));
        int w = 0; w = __builtin_amdgcn_cvt_pk_fp8_f32(R.v[i][0] * sv[0], R.v[i][1] * sv[1], w, false); w = __builtin_amdgcn_cvt_pk_fp8_f32(R.v[i][2] * sv[2], R.v[i][3] * sv[3], w, true);
        __builtin_nontemporal_store(w, (GAS int*)(dst + ((size_t)(2 * i + (lane >> 5)) * NEXP + e) * 128 + 4 * (lane & 31))); }
}
__device__ __forceinline__ void p0_s5_tables(Frame& F_, int item, XPipe& X, bool dox) {
    const int g = item >> 3, tb = item & 7, tid = F_.tid;
    LAS float* pwA = (LAS float*)(F_.lds);
    LAS float* pwB = pwA + 1024;
    LAS float* pwC = pwB + 1024;
    LAS float* bbL = pwC + 1024;
    LAS float* fwA = bbL + 2048;
    const float* lam_re = F_.in[I_LRE]; const float* lam_im = F_.in[I_LIM];
    const float st = expf(F_.in[I_LSTEP][g]);
    {
        const int jj = tid >> 6, p = tid & 63, j = 8 * tb + jj;
        const float lr = lam_re[g * 64 + p], li = lam_im[g * 64 + p];
        const float tA = (float)j * st, tB = (float)(j + 1) * st, tC = (float)(63 - j) * st;
        const float mA = __expf(lr * tA), mB = __expf(lr * tB), mC = __expf(lr * tC);
        pwA[tid * 2] = mA * __cosf(li * tA); pwA[tid * 2 + 1] = mA * __sinf(li * tA);
        pwB[tid * 2] = mB * __cosf(li * tB); pwB[tid * 2 + 1] = mB * __sinf(li * tB);
        pwC[tid * 2] = mC * __cosf(li * tC); pwC[tid * 2 + 1] = mC * __sinf(li * tC);
        if (tb == 0 && jj == 0) { const float t64 = 64.0f * st, m64 = expf(lr * t64); float* a64 = (float*)(F_.ws + WS_A64) + (g * 64 + p) * 2; a64[0] = m64 * cosf(li * t64); a64[1] = m64 * sinf(li * t64); }
    }
    for (int idx = tid; idx < 1024; idx += 512) {
        const int p = idx >> 4, c = idx & 15;
        const float lr = lam_re[g * 64 + p], li = lam_im[g * 64 + p];
        const float mag = expf(lr * st), are = mag * cosf(li * st), aim = mag * sinf(li * st);
        const float den = lr * lr + li * li, nr = are - 1.0f, ni = aim;
        const float cfr = (nr * lr + ni * li) / den, cfi = (ni * lr - nr * li) / den;
        const float br = F_.in[I_BRE][(g * 64 + p) * 16 + c], bi = F_.in[I_BIM][(g * 64 + p) * 16 + c];
        bbL[p * 16 + c] = cfr * br - cfi * bi; bbL[(64 + p) * 16 + c] = cfr * bi + cfi * br;
    }
    __syncthreads();
    bf16* Fg = (bf16*)(F_.ws + WS_F) + (size_t)g * 1024 * 128;
    bf16* Eg = (bf16*)(F_.ws + WS_E) + (size_t)g * 128 * 1024;
    bf16* KTg = (bf16*)(F_.ws + WS_KT) + (size_t)g * 64 * 256;
    for (int idx = tid; idx < 2048; idx += 512) {
        const int oct = idx & 15, c = (idx >> 4) & 15, jj = idx >> 8, p0 = 8 * (oct & 7); const bool isim = oct >> 3;
        const f32x4 cr0 = *(const GAS f32x4*)(F_.in[I_CRE] + (g * 16 + c) * 64 + p0), cr1 = *(const GAS f32x4*)(F_.in[I_CRE] + (g * 16 + c) * 64 + p0 + 4);
        const f32x4 ci0 = *(const GAS f32x4*)(F_.in[I_CIM] + (g * 16 + c) * 64 + p0), ci1 = *(const GAS f32x4*)(F_.in[I_CIM] + (g * 16 + c) * 64 + p0 + 4);
        float fB[8], fA[8];
#pragma unroll
        for (int e = 0; e < 8; ++e) { const float cr = e < 4 ? cr0[e & 3] : cr1[e & 3], ci = e < 4 ? ci0[e & 3] : ci1[e & 3];
            const float br_ = pwB[(jj * 64 + p0 + e) * 2], bi_ = pwB[(jj * 64 + p0 + e) * 2 + 1], ar_ = pwA[(jj * 64 + p0 + e) * 2], ai_ = pwA[(jj * 64 + p0 + e) * 2 + 1];
            fB[e] = isim ? -(cr * bi_ + ci * br_) : (cr * br_ - ci * bi_); fA[e] = isim ? -(cr * ai_ + ci * ar_) : (cr * ar_ - ci * ai_); }
        const int j_ = 8 * tb + jj;
        v4u o; o.x = pk2(fB[0], fB[1]); o.y = pk2(fB[2], fB[3]); o.z = pk2(fB[4], fB[5]); o.w = pk2(fB[6], fB[7]);
        *(GAS v4u*)(Fg + ((size_t)(((j_ >> 1) * 8 + (oct >> 1)) * 64 + (oct & 1) * 32 + (j_ & 1) * 16 + c)) * 8) = o;
        LAS float* fw = fwA + (jj * 16 + c) * 128 + 8 * oct;
        *(LAS f32x4*)fw = (f32x4){fA[0], fA[1], fA[2], fA[3]}; *(LAS f32x4*)(fw + 4) = (f32x4){fA[4], fA[5], fA[6], fA[7]};
    }
    if (dox) {
        const int gw = F_.vcu * NWAVES + F_.wave, NGW = F_.G * NWAVES; const size_t rs = (size_t)NGW * D;
        x_retire(X, rs, F_.in[I_LN1], (bf16*)(F_.ws + WS_R1) + (size_t)gw * D, F_.lane);
        x_issue(X, F_.in[I_X] + (size_t)(gw + 4 * NGW) * D, rs, F_.lane);
    }
    for (int idx = tid; idx < 2048; idx += 512) {
        const int co = idx & 1, jj = (idx >> 1) & 7, pp = idx >> 4, p = pp & 63;
        const float pr = pwC[(jj * 64 + p) * 2], pi = pwC[(jj * 64 + p) * 2 + 1];
        const f32x4 br0 = *(const LAS f32x4*)(bbL + p * 16 + 8 * co), br1 = *(const LAS f32x4*)(bbL + p * 16 + 8 * co + 4);
        const f32x4 bi0 = *(const LAS f32x4*)(bbL + (64 + p) * 16 + 8 * co), bi1 = *(const LAS f32x4*)(bbL + (64 + p) * 16 + 8 * co + 4);
        float v[8];
#pragma unroll
        for (int e = 0; e < 8; ++e) { const float br = e < 4 ? br0[e & 3] : br1[e & 3], bi = e < 4 ? bi0[e & 3] : bi1[e & 3]; v[e] = pp < 64 ? (pr * br - pi * bi) : (pr * bi + pi * br); }
        v4u o; o.x = pk2(v[0], v[1]); o.y = pk2(v[2], v[3]); o.z = pk2(v[4], v[5]); o.w = pk2(v[6], v[7]);
        *(GAS v4u*)(Eg + ((size_t)(((pp >> 5) * 64 + (8 * tb + jj)) * 64 + co * 32 + (pp & 31))) * 8) = o;
    }
    __syncthreads();
    {
        const int cq = tid & 3, c = (tid >> 2) & 15, jj = tid >> 6;
        const LAS float* fr = fwA + (jj * 16 + c) * 128; f32x4 s4 = {0.f, 0.f, 0.f, 0.f};
#pragma unroll 8
        for (int pp = 0; pp < 128; ++pp) s4 += fr[pp] * *(const LAS f32x4*)(bbL + pp * 16 + 4 * cq);
        v2u o; o.x = pk2(s4[0], s4[1]); o.y = pk2(s4[2], s4[3]);
        *(GAS v2u*)(KTg + ((8 * tb + jj) * 16 + c) * 16 + 4 * cq) = o;
    }
    __syncthreads();
}
__device__ __forceinline__ void peer_tables_to_fp8(Frame& F) {
    const int gw = F.vcu * NWAVES + F.wave, NGW = F.G * NWAVES;
    for (int m = gw; m < NEXP; m += 4 * NGW) {
        P0Row a[4], b[4];
#pragma unroll
        for (int r = 0; r < 4; ++r) { p0_fp8_load(a[r], F.in[I_PU] + (size_t)(m + r * NGW) * D, F.lane); p0_fp8_load(b[r], F.in[I_PV] + (size_t)(m + r * NGW) * D, F.lane); }
#pragma unroll
        for (int r = 0; r < 4; ++r) { p0_fp8_store(a[r], F.ws + 18 * MiB, m + r * NGW, F.lane, F.in[I_LN2]); p0_fp8_store(b[r], F.ws + 34 * MiB, m + r * NGW, F.lane); }
    }
}
__device__ __forceinline__ void p0_prologue(Frame& F, int mask = 15) {
    const int gw = F.vcu * NWAVES + F.wave, NGW = F.G * NWAVES;
    const bool dox = (mask & 4) != 0, pipe = dox && (mask & 1) && F.vcu < 256 && T == 8 * NGW; const size_t xrs = (size_t)NGW * D;
    XPipe X;
    if (pipe) x_issue(X, F.in[I_X] + (size_t)gw * D, xrs, F.lane);
    if (mask & 1) for (int it = F.vcu; it < 256; it += F.G) p0_s5_tables(F, it, X, pipe && it == F.vcu);
    if (pipe) x_retire(X, xrs, F.in[I_LN1], (bf16*)(F.ws + WS_R1) + (size_t)(gw + 4 * NGW) * D, F.lane);
    LAS float* scr = (LAS float*)(F.lds + F.wave * 16384);
    constexpr int I1 = 16 * 128, I2 = 8 * 32, I3 = 8 * 32, I4 = 16 * 32, I5 = 16 * 32, I6 = 16 * 32, NIT = I1 + I2 + I3 + I4 + I5 + I6;
    if (mask & 2) {
        auto desc = [&](int it) { TrDesc d; int r = it; d.kscale = nullptr; d.glu = false; d.item = 0; d.W = F.in[I_WIN]; d.WT = (bf16*)(F.ws + WS_W1T); d.K = 1024; d.N = 4096; d.ldw = 1024;
            if (r < I1) { d.item = r; return d; } r -= I1;
            if (r < I2) { d.W = F.in[I_WGLU]; d.WT = (bf16*)(F.ws + WS_WGLUT); d.K = 512; d.N = 1024; d.ldw = 512; d.glu = true; d.item = r; return d; } r -= I2;
            if (r < I3) { d.W = F.in[I_WS5B]; d.WT = (bf16*)(F.ws + WS_WS5T); d.K = 512; d.N = 1024; d.ldw = 1536; d.item = r; return d; } r -= I3;
            if (r < I4) { d.W = F.in[I_WATT]; d.WT = (bf16*)(F.ws + WS_WS5T) + 512; d.K = 1024; d.N = 1024; d.ldw = 1536; d.item = r; return d; } r -= I4;
            if (r < I5) { d.W = F.in[I_WOUT]; d.WT = (bf16*)(F.ws + WS_WOUT); d.K = 1024; d.N = 1024; d.ldw = 1024; d.item = r; return d; } r -= I5;
            d.W = F.in[I_WQ]; d.WT = (bf16*)(F.ws + WS_WQT); d.K = 1024; d.N = 1024; d.ldw = 1024; d.kscale = F.in[I_LN2]; d.item = r; return d; };
        int it = gw;
        if (it < NIT) { TrDesc d = desc(it); TrRegs R; tr_load(d, R, F.lane);
#pragma unroll 1
            for (;;) { const int itn = it + NGW; const bool hn = itn < NIT; TrDesc dn = d; TrRegs Rn = R;
                if (hn) { dn = desc(itn); tr_load(dn, Rn, F.lane); }
                tr_finish(d, R, scr, F.lane);
                if (!hn) break;
                it = itn; d = dn; R = Rn; } }
    }
    if (dox && !pipe) for (int m = gw; m < T; m += 4 * NGW) rms_rows_to_bf16<4>(F.in[I_X] + (size_t)m * D, (size_t)NGW * D, F.in[I_LN1], (bf16*)(F.ws + WS_R1) + (size_t)m * D, F.lane);
    for (int m = gw; m < 128; m += NGW) p0_convert_row(F.in[I_SK] + (size_t)m * D, (bf16*)(F.ws + WS_SKB) + (size_t)m * D, F.lane);
}
__device__ __forceinline__ int crow(int r, int hi) { return (r & 3) + 8 * (r >> 2) + 4 * hi; }
#define MFMA32(a, b, c) __builtin_amdgcn_mfma_f32_32x32x16_bf16((a), (b), (c), 0, 0, 0)
typedef LAS const bf16x8* lds_b8p;
__device__ __forceinline__ bf16x8 lds_ld8(LAS unsigned char* base, int off) { return *(LAS const bf16x8*)(base + off); }
__device__ __forceinline__ float gelu_f(float x) { return 0.5f * x * (1.0f + erff(x * 0.70710678118654752f)); }
typedef float f32x2 __attribute__((ext_vector_type(2)));
__device__ __forceinline__ f32x2 gelu_pk(f32x2 v) {
    const f32x2 av = __builtin_elementwise_abs(v), d = av * 0.2316418882f + 1.0f;
    f32x2 t; t.x = __builtin_amdgcn_rcpf(d.x); t.y = __builtin_amdgcn_rcpf(d.y);
    f32x2 q = t * 0.5307027145f + (-0.7265760135f); q = q * t + 0.7107068705f; q = q * t + (-0.142248368f); q = q * t + 0.127414796f; q = q * t;
    const f32x2 s = (v * v) * (-0.72134752044f);
    f32x2 e; e.x = __builtin_amdgcn_exp2f(s.x); e.y = __builtin_amdgcn_exp2f(s.y);
    const f32x2 m = v * (q * e), r = v - m;
    f32x2 o; o.x = v.x < 0.f ? m.x : r.x; o.y = v.y < 0.f ? m.y : r.y; return o;
}

struct ConvPipe { P0Row a[2], b[2]; f32x4 gs[4]; };
__device__ __forceinline__ void conv_init(Frame& F, ConvPipe& C) {
#pragma unroll
    for (int i = 0; i < 4; ++i) C.gs[i] = *(const GAS f32x4*)(F.in[I_LN2] + 4 * (F.lane + 64 * i)) * 256.0f;
}
__device__ __forceinline__ void conv_issue(Frame& F, ConvPipe& C, int s) {
    const int gw = F.vcu * NWAVES + F.wave, NGW = F.G * NWAVES;
#pragma unroll
    for (int r = 0; r < 2; ++r) { const size_t m = (size_t)(gw + (2 * s + r) * NGW); p0_fp8_load(C.a[r], F.in[I_PU] + m * D, F.lane); p0_fp8_load(C.b[r], F.in[I_PV] + m * D, F.lane); }
}
__device__ __forceinline__ void conv_store_row(const P0Row& R, unsigned char* dst, int e, int lane, const f32x4 (&sc)[4], bool scaled) {
#pragma unroll
    for (int i = 0; i < 4; ++i) { const f32x4 sv = scaled ? sc[i] : (f32x4){256.0f, 256.0f, 256.0f, 256.0f};
        int w = 0; w = __builtin_amdgcn_cvt_pk_fp8_f32(R.v[i][0] * sv[0], R.v[i][1] * sv[1], w, false); w = __builtin_amdgcn_cvt_pk_fp8_f32(R.v[i][2] * sv[2], R.v[i][3] * sv[3], w, true);
        __builtin_nontemporal_store(w, (GAS int*)(dst + ((size_t)(2 * i + (lane >> 5)) * NEXP + e) * 128 + 4 * (lane & 31))); }
}
__device__ __forceinline__ void conv_retire(Frame& F, const ConvPipe& C, int s) {
    const int gw = F.vcu * NWAVES + F.wave, NGW = F.G * NWAVES;
#pragma unroll
    for (int r = 0; r < 2; ++r) { const int m = gw + (2 * s + r) * NGW; conv_store_row(C.a[r], F.ws + 18 * MiB, m, F.lane, C.gs, true); conv_store_row(C.b[r], F.ws + 34 * MiB, m, F.lane, C.gs, false); }
}
constexpr int S5_KT = 0, S5_U = 32768, S5_SX = 98304, S5_H0 = 115200;
template <int VAR> __device__ __forceinline__ void s5_unit(Frame& F, int b, int g, ConvPipe& C) {
    LAS unsigned char* L = F.lds; int tid = F.tid, lane = F.lane; asm volatile("" : "+v"(tid), "+v"(lane));
    const int w = F.wave; int r32 = lane & 31, hi = lane >> 5;
    const bf16* U5 = (const bf16*)(F.ws + WS_U5); bf16* YS5 = (bf16*)(F.ws + WS_YS5);
    const bf16* KTg = (const bf16*)(F.ws + WS_KT) + (size_t)g * 64 * 256;
    const bf16* Eg = (const bf16*)(F.ws + WS_E) + (size_t)g * 128 * 1024;
    const bf16* Fg = (const bf16*)(F.ws + WS_F) + (size_t)g * 1024 * 128;
#pragma unroll
    for (int k = 0; k < 4; ++k) { const int q = tid + 512 * k, lag = q >> 5, c = (q >> 1) & 15, h2 = q & 1;
        *(LAS v4u*)(L + S5_KT + (h2 * 1024 + lag * 16 + c) * 16) = *(const GAS v4u*)(KTg + (size_t)q * 8); }
#pragma unroll
    for (int k = 0; k < 8; ++k) { const int q = tid + 512 * k, l = q >> 1, h2 = q & 1, n = l >> 6, i = l & 63;
        *(LAS v4u*)(L + S5_U + (h2 * 2048 + i * 32 + n) * 16) = *(const GAS v4u*)(U5 + ((size_t)(b * 32 + g) * SEQ + l) * 16 + 8 * h2); }
    LDS_WAIT(); __syncthreads();
    if (VAR == 3) return;
    {
        const int rtE = w & 3, kh = w >> 2; f32x16 acc = {};
        const bf16* erow = Eg + ((size_t)rtE * 64 * 64 + lane) * 8;
#pragma unroll 8
        for (int ii = 0; ii < 32; ++ii) { const int i = 32 * kh + ii;
            const bf16x8 a = *(const GAS bf16x8*)(erow + (size_t)i * 512); const bf16x8 bb = lds_ld8(L, S5_U + (hi * 2048 + i * 32 + r32) * 16);
            acc = MFMA32(a, bb, acc); }
        f32x2 a64v = {0.f, 0.f}; if (tid < 64) a64v = *(const GAS f32x2*)((const float*)(F.ws + WS_A64) + (g * 64 + tid) * 2);
        conv_retire(F, C, 0); conv_issue(F, C, 1);
        LAS float* SX = (LAS float*)(L + S5_SX);
        if (kh == 1) {
#pragma unroll
            for (int r = 0; r < 16; ++r) SX[(32 * rtE + crow(r, hi)) * 33 + r32] = acc[r];
        }
        LDS_WAIT(); __syncthreads();
        if (kh == 0) {
#pragma unroll
            for (int r = 0; r < 16; ++r) SX[(32 * rtE + crow(r, hi)) * 33 + r32] += acc[r];
        }
        LDS_WAIT(); __syncthreads();
        if (tid < 64) {
            const int p = tid; const float ar = a64v[0], ai = a64v[1];
            float hr = 0.f, hm = 0.f;
            const int offr = ((((p >> 4) * 2) + ((p >> 3) & 1)) * 32) * 16 + (p & 7) * 2, offi = (((((64 + p) >> 4) * 2) + ((p >> 3) & 1)) * 32) * 16 + (p & 7) * 2;
            for (int n = 0; n < 32; ++n) {
                *(LAS unsigned short*)(L + S5_H0 + offr + n * 16) = (unsigned short)f2bf(hr);
                *(LAS unsigned short*)(L + S5_H0 + offi + n * 16) = (unsigned short)f2bf(hm);
                const float sr = SX[p * 33 + n], si = SX[(64 + p) * 33 + n];
                const float nr = ar * hr - ai * hm + sr, ni = ar * hm + ai * hr + si; hr = nr; hm = ni;
            }
        }
        LDS_WAIT(); __syncthreads();
    }
    if (VAR == 1) return;
    const f32x4 dsk = *(const GAS f32x4*)(F.in[I_S5D] + g * 16 + 4 * hi), dsk8 = *(const GAS f32x4*)(F.in[I_S5D] + g * 16 + 8 + 4 * hi);
#pragma unroll 1
    for (int q = 0; q < 4; ++q) {
        const int rt = (q == 0) ? w : (q == 1) ? 15 - w : (q == 2) ? 16 + w : 31 - w;
        { int lo_ = lane; asm volatile("" : "+v"(lo_)); r32 = lo_ & 31; hi = lo_ >> 5; }
        const int jl = r32 >> 4, c = r32 & 15;
        f32x16 acc = {};
        const int abase = S5_KT + (hi * 1024 + (2 * rt + jl) * 16 + c) * 16, bbase = S5_U + (hi * 2048 + r32) * 16;
        bf16x8 ff[8];
        { const bf16* frow_ = Fg + ((size_t)rt * 8 * 64 + lane) * 8;
#pragma unroll
          for (int ks = 0; ks < 8; ++ks) ff[ks] = *(const GAS bf16x8*)(frow_ + ks * 512); }
        if (q < 3) { conv_retire(F, C, q + 1); if (q < 2) conv_issue(F, C, q + 2); }
        { bf16x8 an = lds_ld8(L, abase), bn = lds_ld8(L, bbase);
#pragma unroll 4
          for (int i = 0; i <= 2 * rt; ++i) { const bf16x8 a = an, bb = bn; const int i1 = (i < 2 * rt) ? i + 1 : i; an = lds_ld8(L, abase - i1 * 256); bn = lds_ld8(L, bbase + i1 * 512); acc = MFMA32(a, bb, acc); } }
        { const int i = 2 * rt + 1; bf16x8 a = lds_ld8(L, S5_KT + (hi * 1024 + c) * 16); if (jl == 0) a = (bf16x8){0, 0, 0, 0, 0, 0, 0, 0};
          const bf16x8 bb = lds_ld8(L, bbase + i * 512); acc = MFMA32(a, bb, acc); }
#pragma unroll
        for (int ks = 0; ks < 8; ++ks) { const bf16x8 bb = lds_ld8(L, S5_H0 + ((ks * 2 + hi) * 32 + r32) * 16); acc = MFMA32(ff[ks], bb, acc); }
        if (VAR == 2) { asm volatile("" :: "v"(acc[0]), "v"(acc[5]), "v"(acc[10]), "v"(acc[15])); continue; }
#pragma unroll
        for (int gq = 0; gq < 4; ++gq) {
            const int jl2 = gq >> 1, i = 2 * rt + jl2;
            const v2u uu = *(LAS const v2u*)(L + S5_U + ((gq & 1) * 2048 + i * 32 + r32) * 16 + 8 * hi);
            const f32x4 dd = (gq & 1) ? dsk8 : dsk;
            const f32x2 y01 = gelu_pk((f32x2){acc[4 * gq + 0] + dd[0] * blo(uu.x), acc[4 * gq + 1] + dd[1] * bhi(uu.x)});
            const f32x2 y23 = gelu_pk((f32x2){acc[4 * gq + 2] + dd[2] * blo(uu.y), acc[4 * gq + 3] + dd[3] * bhi(uu.y)});
            v2u o; o.x = pk2(y01.x, y01.y); o.y = pk2(y23.x, y23.y);
            *(GAS v2u*)(YS5 + ((size_t)b * SEQ + 64 * r32 + i) * 512 + g * 16 + 8 * (gq & 1) + 4 * hi) = o;
        }
    }
    LDS_WAIT(); __syncthreads();
}

constexpr int AT_K = 0, AT_V = 32768, AT_B = 66048, AT_VSTR = 520;
constexpr float LOG2E = 1.4426950408889634f;
__device__ __forceinline__ int t5_bucket_d(int dist) { if (dist < 16) return dist; const int v = 16 + (int)(logf((float)dist / 16.0f) / logf(8.0f) * 16.0f); return v < 31 ? v : 31; }
constexpr int AT_BUF_BYTES = 69632;
static_assert(AT_B + 4 * 224 * 4 <= AT_BUF_BYTES && 2 * AT_BUF_BYTES + 2048 <= LDSCTL_OFF, "attention LDS map");
struct AttnKV { v4u kr[4], vr[4]; };
__device__ __forceinline__ void attn_load(Frame& F, AttnKV& R, int b, int kvh, int n) {
    const bf16* Kb = (const bf16*)(F.ws + WS_K); const bf16* Vb = (const bf16*)(F.ws + WS_V);
    int tid_o = F.tid; asm volatile("" : "+v"(tid_o));
#pragma unroll
    for (int k = 0; k < 4; ++k) { const int q = tid_o + 512 * k, key = q >> 3, ch = q & 7, kpos = 128 * (n - 1) + key;
        R.kr[k] = (v4u){0u, 0u, 0u, 0u}; R.vr[k] = (v4u){0u, 0u, 0u, 0u};
        if (kpos >= 0) { R.kr[k] = *(const GAS v4u*)(Kb + ((size_t)b * SEQ + kpos) * 256 + kvh * 64 + 8 * ch); R.vr[k] = *(const GAS v4u*)(Vb + ((size_t)b * SEQ + kpos) * 256 + kvh * 64 + 8 * ch); } }
}
__device__ __forceinline__ void attn_stage(Frame& F, const AttnKV& R, LAS unsigned char* L, int kvh) {
    int tid = F.tid; asm volatile("" : "+v"(tid));
#pragma unroll
    for (int k = 0; k < 4; ++k) {
        const int q = tid + 512 * k, key = q >> 3, ch = q & 7;
        const v4u kr = R.kr[k], vr = R.vr[k];
        float kf[8] = {blo(kr.x), bhi(kr.x), blo(kr.y), bhi(kr.y), blo(kr.z), bhi(kr.z), blo(kr.w), bhi(kr.w)};
        float ss = 0.f;
#pragma unroll
        for (int j = 0; j < 8; ++j) ss += kf[j] * kf[j];
        ss += __shfl_xor(ss, 1); ss += __shfl_xor(ss, 2); ss += __shfl_xor(ss, 4);
        const float rk = rsqrtf(ss * (1.0f / 64.0f) + RMS_EPS);
        const f32x4 g0 = *(const GAS f32x4*)(F.in[I_GK] + 8 * ch) * *(const GAS f32x4*)(F.in[I_GQ] + 8 * ch), g1 = *(const GAS f32x4*)(F.in[I_GK] + 8 * ch + 4) * *(const GAS f32x4*)(F.in[I_GQ] + 8 * ch + 4);
        v4u o; o.x = pk2(kf[0] * rk * g0[0], kf[1] * rk * g0[1]); o.y = pk2(kf[2] * rk * g0[2], kf[3] * rk * g0[3]);
        o.z = pk2(kf[4] * rk * g1[0], kf[5] * rk * g1[1]); o.w = pk2(kf[6] * rk * g1[2], kf[7] * rk * g1[3]);
        *(LAS v4u*)(L + AT_K + key * 128 + ((ch ^ (key & 7)) * 16)) = o;
        LAS unsigned short* vt = (LAS unsigned short*)(L + AT_V + (8 * ch) * AT_VSTR + key * 2);
        vt[0 * (AT_VSTR / 2)] = (unsigned short)(vr.x & 0xffffu); vt[1 * (AT_VSTR / 2)] = (unsigned short)(vr.x >> 16);
        vt[2 * (AT_VSTR / 2)] = (unsigned short)(vr.y & 0xffffu); vt[3 * (AT_VSTR / 2)] = (unsigned short)(vr.y >> 16);
        vt[4 * (AT_VSTR / 2)] = (unsigned short)(vr.z & 0xffffu); vt[5 * (AT_VSTR / 2)] = (unsigned short)(vr.z >> 16);
        vt[6 * (AT_VSTR / 2)] = (unsigned short)(vr.w & 0xffffu); vt[7 * (AT_VSTR / 2)] = (unsigned short)(vr.w >> 16);
    }
    { const int g = tid >> 7, dist = tid & 127; ((LAS float*)(L + AT_B))[g * 224 + 159 - dist] = F.in[I_BIAS][t5_bucket_d(dist) * 16 + 4 * kvh + g] * LOG2E; }
}
template <int VAR> __device__ __forceinline__ void attn_compute(Frame& F, LAS unsigned char* L, int b, int kvh, int n) {
    int lane = F.lane; asm volatile("" : "+v"(lane));
    const int w = F.wave, r32 = lane & 31, hi = lane >> 5;
    const bf16* Qb = (const bf16*)(F.ws + WS_Q); bf16* ATT = (bf16*)(F.ws + WS_R1);
    const int g = w >> 1, half = w & 1, h = 4 * kvh + g;
    const float sinkl = F.in[I_SINK][h] * LOG2E;
    const LAS float* BLg = (const LAS float*)(L + AT_B) + g * 224;
#pragma unroll 1
    for (int a2 = 0; a2 < 2; ++a2) {
        const int a = 2 * half + a2;
        int r32o = r32, hio = hi; asm volatile("" : "+v"(r32o), "+v"(hio));
        const size_t trow = (size_t)b * SEQ + 128 * n + 32 * a + r32o;
        bf16x8 qb[4];
        {
            v4u qr[4]; float ss = 0.f;
#pragma unroll
            for (int ks = 0; ks < 4; ++ks) { qr[ks] = *(const GAS v4u*)(Qb + trow * 1024 + h * 64 + 16 * ks + 8 * hio);
                const float f0 = blo(qr[ks].x), f1 = bhi(qr[ks].x), f2 = blo(qr[ks].y), f3 = bhi(qr[ks].y), f4 = blo(qr[ks].z), f5 = bhi(qr[ks].z), f6 = blo(qr[ks].w), f7 = bhi(qr[ks].w);
                ss += (f0 * f0 + f1 * f1) + (f2 * f2 + f3 * f3) + (f4 * f4 + f5 * f5) + (f6 * f6 + f7 * f7); }
            ss += __shfl_xor(ss, 32);
            const float rq = rsqrtf(ss * (1.0f / 64.0f) + RMS_EPS) * (0.125f * LOG2E);
#pragma unroll
            for (int ks = 0; ks < 4; ++ks) {
                v4u o; o.x = pk2(blo(qr[ks].x) * rq, bhi(qr[ks].x) * rq); o.y = pk2(blo(qr[ks].y) * rq, bhi(qr[ks].y) * rq);
                o.z = pk2(blo(qr[ks].z) * rq, bhi(qr[ks].z) * rq); o.w = pk2(blo(qr[ks].w) * rq, bhi(qr[ks].w) * rq);
                qb[ks] = __builtin_bit_cast(bf16x8, o); }
        }
        f32x16 p[5]; float m = -1e30f;
        int r32v = r32o - 4 * hio; asm volatile("" : "+v"(r32v));
        const LAS float* BLl = BLg + (31 - r32v);
#pragma unroll
        for (int kt = 0; kt < 5; ++kt) {
            f32x16 ci;
            const int key = 32 * (a + kt) + r32o;
            bf16x8 kfr[4];
#pragma unroll
            for (int ks = 0; ks < 4; ++ks) kfr[ks] = lds_ld8(L, AT_K + key * 128 + (((2 * ks + hio) ^ (key & 7)) * 16));
            const bool tile_ok = (n > 0) || (a + kt >= 4);
#pragma unroll
            for (int r = 0; r < 16; ++r) { const int cc = (r & 3) + 8 * (r >> 2);
                const float bv = BLl[32 * kt + cc];
                ci[r] = (kt == 0) ? ((cc > r32v) ? bv : -1e30f) : (kt == 4) ? ((cc <= r32v) ? bv : -1e30f) : bv; }
            if (!tile_ok) {
#pragma unroll
                for (int r = 0; r < 16; ++r) ci[r] = -1e30f;
            }
#pragma unroll
            for (int ks = 0; ks < 4; ++ks) ci = MFMA32(kfr[ks], qb[ks], ci);
            p[kt] = ci;
#pragma unroll
            for (int r = 0; r < 16; ++r) m = fmaxf(m, ci[r]);
        }
        if (VAR == 1) { asm volatile("" :: "v"(p[0][0]), "v"(p[1][3]), "v"(p[2][7]), "v"(p[3][11]), "v"(p[4][15]), "v"(m)); continue; }
        m = fmaxf(m, __shfl_xor(m, 32)); m = fmaxf(m, sinkl);
        float l = 0.f;
#pragma unroll
        for (int kt = 0; kt < 5; ++kt)
#pragma unroll
            for (int r = 0; r < 16; ++r) { const float e = __builtin_amdgcn_exp2f(p[kt][r] - m); p[kt][r] = e; l += e; }
        l += __shfl_xor(l, 32); l += __builtin_amdgcn_exp2f(sinkl - m);
        const float inv = 1.0f / l;
        f32x16 o[2]; o[0] = (f32x16){}; o[1] = (f32x16){};
#pragma unroll
        for (int kt = 0; kt < 5; ++kt)
#pragma unroll
            for (int s2 = 0; s2 < 2; ++s2) {
                v4u pw; pw.x = pk2(p[kt][8 * s2 + 0] * inv, p[kt][8 * s2 + 1] * inv); pw.y = pk2(p[kt][8 * s2 + 2] * inv, p[kt][8 * s2 + 3] * inv);
                pw.z = pk2(p[kt][8 * s2 + 4] * inv, p[kt][8 * s2 + 5] * inv); pw.w = pk2(p[kt][8 * s2 + 6] * inv, p[kt][8 * s2 + 7] * inv);
                const bf16x8 pa = __builtin_bit_cast(bf16x8, pw);
                const int base = 32 * (a + kt) + 16 * s2;
                v4u vv[2];
#pragma unroll
                for (int dt = 0; dt < 2; ++dt) { const int voff = AT_V + (32 * dt + r32o) * AT_VSTR + (base + 4 * hio) * 2;
                    const v2u lo = *(LAS const v2u*)(L + voff), h2 = *(LAS const v2u*)(L + voff + 16);
                    vv[dt] = (v4u){lo.x, lo.y, h2.x, h2.y}; }
#pragma unroll
                for (int dt = 0; dt < 2; ++dt) o[dt] = MFMA32(pa, __builtin_bit_cast(bf16x8, vv[dt]), o[dt]);
            }
        if (VAR == 2) { asm volatile("" :: "v"(o[0][0]), "v"(o[0][9]), "v"(o[1][5]), "v"(o[1][15])); continue; }
        bf16* orow = ATT + ((size_t)b * SEQ + 128 * n + 32 * a) * 1024 + h * 64 + r32o;
#pragma unroll
        for (int dt = 0; dt < 2; ++dt)
#pragma unroll
            for (int r = 0; r < 16; ++r) orow[(size_t)crow(r, hio) * 1024 + 32 * dt] = (bf16)f2bf(o[dt][r]);
    }
}
constexpr int AT_DUMMY_OFF = 2 * AT_BUF_BYTES;
__device__ __forceinline__ void attn_prefetch(Frame& F, int b, int kvh, int n) {
    const bf16* Kb = (const bf16*)(F.ws + WS_K); const bf16* Vb = (const bf16*)(F.ws + WS_V);
    LAS unsigned* dst = (LAS unsigned*)(F.lds + AT_DUMMY_OFF + F.wave * 256);
    int tid_o = F.tid; asm volatile("" : "+v"(tid_o));
#pragma unroll
    for (int k = 0; k < 4; ++k) { const int q = tid_o + 512 * k, key = q >> 3, ch = q & 7; int kpos = 128 * (n - 1) + key; kpos = kpos < 0 ? 0 : kpos;
        __builtin_amdgcn_global_load_lds((const GAS unsigned*)(Kb + ((size_t)b * SEQ + kpos) * 256 + kvh * 64 + 8 * ch), dst, 4, 0, 0);
        __builtin_amdgcn_global_load_lds((const GAS unsigned*)(Vb + ((size_t)b * SEQ + kpos) * 256 + kvh * 64 + 8 * ch), dst, 4, 0, 0); }
}
__device__ __forceinline__ void mixers_phase(Frame& F, ConvPipe& C) {
    const int NU = BATCH * NKV * 16;
    { const int u0 = F.vcu, u1 = u0 + F.G;
      if (u0 < NU) attn_prefetch(F, u0 >> 6, (u0 >> 4) & 3, u0 & 15);
      if (u1 < NU) attn_prefetch(F, u1 >> 6, (u1 >> 4) & 3, u1 & 15); }
    for (int u = F.vcu; u < BATCH * S5NG; u += F.G) s5_unit<0>(F, u >> 5, u & 31, C);
#pragma unroll 1
    for (int u0 = F.vcu; u0 < NU; u0 += 2 * F.G) {
        const int u1 = u0 + F.G; const bool has1 = u1 < NU;
        AttnKV R0, R1;
        attn_load(F, R0, u0 >> 6, (u0 >> 4) & 3, u0 & 15);
        if (has1) attn_load(F, R1, u1 >> 6, (u1 >> 4) & 3, u1 & 15);
        attn_stage(F, R0, F.lds, (u0 >> 4) & 3);
        if (has1) attn_stage(F, R1, F.lds + AT_BUF_BYTES, (u1 >> 4) & 3);
        LDS_WAIT(); __syncthreads();
        attn_compute<0>(F, F.lds, u0 >> 6, (u0 >> 4) & 3, u0 & 15);
        if (has1) attn_compute<0>(F, F.lds + AT_BUF_BYTES, u1 >> 6, (u1 >> 4) & 3, u1 & 15);
        LDS_WAIT(); __syncthreads();
    }
}
__device__ __forceinline__ int f2ord(float f) { int b = __builtin_bit_cast(int, f); return b ^ ((b >> 31) & 0x7fffffff); }
__device__ __forceinline__ float ord2f(int b) { return __builtin_bit_cast(float, b ^ ((b >> 31) & 0x7fffffff)); }
#define CE_DESC(a, b) do { const int t_ = max((a), (b)); (b) = min((a), (b)); (a) = t_; } while (0)
__device__ __forceinline__ void sort16_desc(int (&v)[16]) {
#pragma unroll
    for (int k = 2; k <= 16; k <<= 1)
#pragma unroll
        for (int j = k >> 1; j > 0; j >>= 1)
#pragma unroll
            for (int i = 0; i < 16; ++i) { const int l = i ^ j; if (l > i) { if ((i & k) == 0 || k == 16) CE_DESC(v[i], v[l]); else CE_DESC(v[l], v[i]); } }
}
__device__ __forceinline__ void bitonic_merge16_desc(int (&v)[16]) {
#pragma unroll
    for (int j = 8; j > 0; j >>= 1)
#pragma unroll
        for (int i = 0; i < 16; ++i) { const int l = i ^ j; if (l > i) CE_DESC(v[i], v[l]); }
}
__device__ __forceinline__ void merge_top16(int (&A)[16], const int (&B)[16]) {
#pragma unroll
    for (int i = 0; i < 16; ++i) A[i] = max(A[i], B[15 - i]);
    bitonic_merge16_desc(A);
}
__device__ __forceinline__ void merge_partner(int (&A)[16]) {
    int B[16];
#pragma unroll
    for (int i = 0; i < 16; ++i) B[i] = __shfl_xor(A[i], 32);
    merge_top16(A, B);
}
constexpr int TK_LDS_PER_WAVE = 2048;
constexpr int TK_SK_BYTES = 32768, TK_SCR_OFF = 2 * TK_SK_BYTES;
__device__ __forceinline__ void topk_item(Frame& F, int tile, int h, int skoff) {
    const int lane = F.lane, r32 = lane & 31, hi = lane >> 5;
    const bf16* QP = (const bf16*)(F.ws + WS_QP);
    unsigned short* EXP = (unsigned short*)(F.ws + WS_EXP); float* GATE = (float*)(F.ws + WS_GATE);
    const int t = tile * 32 + r32;
    int L[2][16];
#pragma unroll
    for (int k = 0; k < 2; ++k) {
        bf16x8 qb[4];
#pragma unroll
        for (int ks = 0; ks < 4; ++ks) qb[ks] = *(const GAS bf16x8*)(QP + (size_t)t * 1024 + h * 128 + k * 64 + 16 * ks + 8 * hi);
        int top[16];
#pragma unroll
        for (int rt = 0; rt < 4; ++rt) {
            f32x16 acc = {};
#pragma unroll
            for (int ks = 0; ks < 4; ++ks) { const bf16x8 a = lds_ld8(F.lds, skoff + (((k * 4 + rt) * 4 + ks) * 64 + lane) * 16); acc = MFMA32(a, qb[ks], acc); }
            int v[16];
#pragma unroll
            for (int r = 0; r < 16; ++r) v[r] = (f2ord(acc[r]) & ~127) | (127 - 32 * rt - (r & 3) - 8 * (r >> 2) - 4 * hi);
            sort16_desc(v);
            if (rt == 0) {
#pragma unroll
                for (int i = 0; i < 16; ++i) top[i] = v[i];
            } else merge_top16(top, v);
        }
        merge_partner(top);
#pragma unroll
        for (int i = 0; i < 16; ++i) L[k][i] = top[i];
    }
    LAS unsigned char* tl = F.lds + TK_SCR_OFF + F.wave * TK_LDS_PER_WAVE + lane * 32;
#pragma unroll
    for (int k = 0; k < 2; ++k) { v4u w;
        w.x = (127 - (L[k][0] & 127)) | ((127 - (L[k][1] & 127)) << 8) | ((127 - (L[k][2] & 127)) << 16) | ((127 - (L[k][3] & 127)) << 24);
        w.y = (127 - (L[k][4] & 127)) | ((127 - (L[k][5] & 127)) << 8) | ((127 - (L[k][6] & 127)) << 16) | ((127 - (L[k][7] & 127)) << 24);
        w.z = (127 - (L[k][8] & 127)) | ((127 - (L[k][9] & 127)) << 8) | ((127 - (L[k][10] & 127)) << 16) | ((127 - (L[k][11] & 127)) << 24);
        w.w = (127 - (L[k][12] & 127)) | ((127 - (L[k][13] & 127)) << 8) | ((127 - (L[k][14] & 127)) << 16) | ((127 - (L[k][15] & 127)) << 24);
        *(LAS v4u*)(tl + 16 * k) = w; }
    float A[16], B[16];
#pragma unroll
    for (int i = 0; i < 16; ++i) { const float v1 = ord2f(L[0][i] & ~127), v2 = ord2f(L[1][i] & ~127); A[i] = hi ? v2 : v1; B[i] = hi ? v1 : v2; }
    int c0[16], c1[16];
    const int hcode = hi << 5;
#pragma unroll
    for (int j = 0; j < 16; ++j) c0[j] = (f2ord(A[0] + B[j]) & ~63) | (hcode + j);
#pragma unroll
    for (int j = 1; j < 8; ++j) c1[j - 1] = (f2ord(A[1] + B[j]) & ~63) | (hcode + 15 + j);
#pragma unroll
    for (int j = 2; j < 5; ++j) c1[5 + j] = (f2ord(A[2] + B[j]) & ~63) | (hcode + 21 + j);
    c1[10] = (f2ord(A[3] + B[3]) & ~63) | (hcode + 26);
#pragma unroll
    for (int j = 11; j < 16; ++j) c1[j] = (int)0x80000000;
    if (hi) { c0[0] = (int)0x80000000; c1[0] = (int)0x80000000; c1[7] = (int)0x80000000; c1[10] = (int)0x80000000; }
    sort16_desc(c0); sort16_desc(c1); merge_top16(c0, c1); merge_partner(c0);
    LDS_WAIT();
    float vals[16]; int eid[16];
    const LAS unsigned char* tb = F.lds + TK_SCR_OFF + F.wave * TK_LDS_PER_WAVE + (lane & 31) * 32;
#pragma unroll
    for (int r = 0; r < 16; ++r) {
        const int key = c0[r], code = key & 63, hs = code >> 5, pid = code & 31;
        const int i = (pid >= 16) + (pid >= 23) + (pid >= 26);
        const int j = pid - (i == 0 ? 0 : i == 1 ? 16 : i == 2 ? 23 : 26) + i;
        const int i1 = hs ? j : i, i2 = hs ? i : j;
        eid[r] = (int)tb[i1] * 128 + (int)tb[16 + i2];
        vals[r] = ord2f(key & ~63);
    }
    float sum = 0.f; const float mx = vals[0];
#pragma unroll
    for (int r = 0; r < 16; ++r) { vals[r] = __expf(vals[r] - mx); sum += vals[r]; }
    const float inv = 1.0f / sum;
    int eo[8]; float go[8];
#pragma unroll
    for (int r = 0; r < 8; ++r) { eo[r] = hi ? eid[r + 8] : eid[r]; go[r] = (hi ? vals[r + 8] : vals[r]) * inv; }
    const size_t ob = (size_t)t * 128 + h * 16 + 8 * hi;
    *(GAS v4u*)(EXP + ob) = (v4u){(unsigned)eo[0] | ((unsigned)eo[1] << 16), (unsigned)eo[2] | ((unsigned)eo[3] << 16), (unsigned)eo[4] | ((unsigned)eo[5] << 16), (unsigned)eo[6] | ((unsigned)eo[7] << 16)};
    *(GAS f32x4*)(GATE + ob) = (f32x4){go[0], go[1], go[2], go[3]};
    *(GAS f32x4*)(GATE + ob + 4) = (f32x4){go[4], go[5], go[6], go[7]};
    LDS_WAIT();
}
__device__ __forceinline__ void topk_unit(Frame& F, int pm, int pn) {
    const bf16* SKb = (const bf16*)(F.ws + WS_SKB);
#pragma unroll
    for (int i = 0; i < 8; ++i) { const int q = F.tid + 512 * i, hh = q >> 11, qq = q & 2047, k = qq >> 10, n = (qq >> 3) & 127, dc = qq & 7;
        const v4u v = *(const GAS v4u*)(SKb + ((size_t)(((2 * pn + hh) * 2 + k) * 128 + n)) * 64 + 8 * dc);
        *(LAS v4u*)(F.lds + hh * TK_SK_BYTES + (((k * 4 + (n >> 5)) * 4 + (dc >> 1)) * 64 + (dc & 1) * 32 + (n & 31)) * 16) = v; }
    LDS_WAIT(); __syncthreads();
    topk_item(F, pm * 8 + F.wave, 2 * pn, 0);
    topk_item(F, pm * 8 + F.wave, 2 * pn + 1, TK_SK_BYTES);
    LDS_WAIT(); __syncthreads();
}
typedef unsigned char u8;
constexpr size_t WS_U8 = 18 * MiB, WS_V8 = 34 * MiB, WS_ACT = 50 * MiB, WS_XH8 = 58 * MiB, WS_XL8 = 74 * MiB, WS_P = 147 * MiB;
static_assert(WS_P + 64 * MiB <= WS_END && WS_XL8 + 16 * MiB <= WS_R1, "ws map (PEER)");
constexpr float PEER_TAB_SCALE = 256.0f, PEER_INV_SCALE = 1.0f / 256.0f;
#define MFMA16F8(a, b, c) __builtin_amdgcn_mfma_f32_16x16x32_fp8_fp8((a), (b), (c), 0, 0, 0)
__device__ __forceinline__ long mk64(unsigned lo, unsigned hi) { return (long)(((unsigned long long)hi << 32) | lo); }

struct PeerRows { v4u r[16]; };
struct PeerVTok { v4u av[2]; v4u ev[2]; };
template <int CTRL> __device__ __forceinline__ float dpp_mov(float v) { return __builtin_bit_cast(float, __builtin_amdgcn_update_dpp(0, __builtin_bit_cast(int, v), CTRL, 0xF, 0xF, true)); }
__device__ __forceinline__ void peer_u_meta(v4u (&ev)[2], const unsigned short* EXP, int t, int g8) {
#pragma unroll
    for (int k = 0; k < 2; ++k) ev[k] = *(const GAS v4u*)(EXP + (size_t)t * 128 + 16 * g8 + 8 * k);
}
typedef __amdgpu_buffer_rsrc_t peer_rsrc_t;
__device__ __forceinline__ v4u peer_ld_row(peer_rsrc_t rs, unsigned id, unsigned c16) { return __builtin_amdgcn_raw_buffer_load_b128(rs, (id << 7) | c16, 0, 0); }
__device__ __forceinline__ unsigned peer_id(const v4u (&ev)[2], int k) { const unsigned w = ev[k >> 3][(k >> 1) & 3]; return (k & 1) ? (w >> 16) : (w & 0xffffu); }
__device__ __forceinline__ void peer_rows16(PeerRows& R, peer_rsrc_t rs, unsigned c16, const v4u (&ev)[2]) {
#pragma unroll
    for (int k = 0; k < 16; ++k) R.r[k] = peer_ld_row(rs, peer_id(ev, k), c16);
}
__device__ __forceinline__ void peer_u_token(PeerRows& R, peer_rsrc_t rs, unsigned c16, const v4u (&enext)[2], v4u x0, v4u x1, unsigned* op, bool b0, bool b1, bool b2) {
    typedef _Float16 h2_t __attribute__((ext_vector_type(2)));
    h2_t xh[8];
    xh[0] = __builtin_bit_cast(h2_t, __builtin_amdgcn_cvt_pkrtz(blo(x0.x), bhi(x0.x))); xh[1] = __builtin_bit_cast(h2_t, __builtin_amdgcn_cvt_pkrtz(blo(x0.y), bhi(x0.y)));
    xh[2] = __builtin_bit_cast(h2_t, __builtin_amdgcn_cvt_pkrtz(blo(x0.z), bhi(x0.z))); xh[3] = __builtin_bit_cast(h2_t, __builtin_amdgcn_cvt_pkrtz(blo(x0.w), bhi(x0.w)));
    xh[4] = __builtin_bit_cast(h2_t, __builtin_amdgcn_cvt_pkrtz(blo(x1.x), bhi(x1.x))); xh[5] = __builtin_bit_cast(h2_t, __builtin_amdgcn_cvt_pkrtz(blo(x1.y), bhi(x1.y)));
    xh[6] = __builtin_bit_cast(h2_t, __builtin_amdgcn_cvt_pkrtz(blo(x1.z), bhi(x1.z))); xh[7] = __builtin_bit_cast(h2_t, __builtin_amdgcn_cvt_pkrtz(blo(x1.w), bhi(x1.w)));
    float d[16];
#pragma unroll
    for (int k = 0; k < 16; ++k) { const v4u rk = R.r[k];
        R.r[k] = peer_ld_row(rs, peer_id(enext, k), c16);
        float s0 = 0.f, s1 = 0.f;
#pragma unroll
        for (int dw = 0; dw < 4; ++dw) {
            s0 = __builtin_amdgcn_fdot2(__builtin_amdgcn_cvt_scalef32_pk_f16_fp8(rk[dw], 1.0f, false), xh[2 * dw], s0, false);
            s1 = __builtin_amdgcn_fdot2(__builtin_amdgcn_cvt_scalef32_pk_f16_fp8(rk[dw], 1.0f, true), xh[2 * dw + 1], s1, false); }
        d[k] = s0 + s1; }
    float r8[8], r4[4], r2[2];
#pragma unroll
    for (int i = 0; i < 8; ++i) { const float send = b0 ? d[i] : d[i + 8], keep = b0 ? d[i + 8] : d[i]; r8[i] = keep + dpp_mov<0xB1>(send); }
#pragma unroll
    for (int i = 0; i < 4; ++i) { const float send = b1 ? r8[i] : r8[i + 4], keep = b1 ? r8[i + 4] : r8[i]; r4[i] = keep + dpp_mov<0x4E>(send); }
#pragma unroll
    for (int i = 0; i < 2; ++i) { const float send = b2 ? r4[i] : r4[i + 2], keep = b2 ? r4[i + 2] : r4[i]; r2[i] = keep + __shfl_xor(send, 4); }
    *(GAS unsigned*)op = pk2(r2[0], r2[1]);
}
__device__ __forceinline__ void peer_u_phase(Frame& F) {
    const int lane = F.lane, w = F.wave, g8 = lane >> 3, c = lane & 7;
    const int x = blockIdx.x & 7, nj = F.G >> 3, j = blockIdx.x >> 3, tpw = T / nj;
    const peer_rsrc_t Us = __builtin_amdgcn_make_buffer_rsrc((void*)(F.ws + WS_U8 + (size_t)x * NEXP * 128), (short)0, NEXP * 128, 0x00020000); const unsigned c16 = 16u * (unsigned)c;
    const bf16* XN2 = (const bf16*)(F.ws + WS_R1) + 128 * x + 16 * c;
    const unsigned short* EXP = (const unsigned short*)(F.ws + WS_EXP); unsigned* P = (unsigned*)(F.ws + WS_P) + (size_t)x * T * 64;
    const bool b0 = lane & 1, b1 = lane & 2, b2 = lane & 4;
    const int slot = 16 * g8 + 8 * (b0 ? 1 : 0) + 4 * (b1 ? 1 : 0) + 2 * (b2 ? 1 : 0);
    const int nold = (tpw * 3) / 4, STR = 4;
    const int t0 = j * tpw + ((w < 4) ? w : nold + (w - 4)), tend = j * tpw + ((w < 4) ? nold : tpw);
    if (t0 >= tend) return;
#define TCL(tt) (((tt) < tend) ? (tt) : t0)
    v4u eA[2], eB[2]; PeerRows RA, RB;
    peer_u_meta(eA, EXP, t0, g8); peer_u_meta(eB, EXP, TCL(t0 + STR), g8);
    peer_rows16(RA, Us, c16, eA); peer_rows16(RB, Us, c16, eB);
    peer_u_meta(eA, EXP, TCL(t0 + 2 * STR), g8); peer_u_meta(eB, EXP, TCL(t0 + 3 * STR), g8);
#pragma unroll 1
    for (int t = t0; t < tend; t += 2 * STR) {
        const int tb = TCL(t + STR);
        const v4u xa0 = *(const GAS v4u*)(XN2 + (size_t)t * 1024), xa1 = *(const GAS v4u*)(XN2 + (size_t)t * 1024 + 8);
        const v4u xb0 = *(const GAS v4u*)(XN2 + (size_t)tb * 1024), xb1 = *(const GAS v4u*)(XN2 + (size_t)tb * 1024 + 8);
        peer_u_token(RA, Us, c16, eA, xa0, xa1, P + ((size_t)t * 128 + slot) / 2, b0, b1, b2);
        peer_u_meta(eA, EXP, TCL(t + 4 * STR), g8);
        if (t + STR < tend) peer_u_token(RB, Us, c16, eB, xb0, xb1, P + ((size_t)tb * 128 + slot) / 2, b0, b1, b2);
        peer_u_meta(eB, EXP, TCL(t + 5 * STR), g8);
    }
#undef TCL
}
__device__ __forceinline__ void peer_combine_phase(Frame& F) {
    const v2u* P = (const v2u*)(F.ws + WS_P); const float* GATE = (const float*)(F.ws + WS_GATE); v2u* ACT = (v2u*)(F.ws + WS_ACT); const float* RR = (const float*)(F.ws + WS_RROW);
    const int gt = F.vcu * (NWAVES * 64) + F.tid, NGT = F.G * NWAVES * 64;
    for (int i = gt; i < T * 32; i += NGT) {
        f32x4 s = {0.f, 0.f, 0.f, 0.f};
#pragma unroll
        for (int x = 0; x < 8; ++x) { const v2u w = *(const GAS v2u*)(P + (size_t)x * T * 32 + i); s += (f32x4){blo(w.x), bhi(w.x), blo(w.y), bhi(w.y)}; }
        const f32x4 g = *(const GAS f32x4*)(GATE + (size_t)i * 4);
        f32x4 o;
        const float rs = RR[i >> 5] * PEER_INV_SCALE;
        { const f32x2 g01 = gelu_pk((f32x2){s[0] * rs, s[1] * rs}), g23 = gelu_pk((f32x2){s[2] * rs, s[3] * rs});
          o[0] = g[0] * g01.x * PEER_INV_SCALE; o[1] = g[1] * g01.y * PEER_INV_SCALE; o[2] = g[2] * g23.x * PEER_INV_SCALE; o[3] = g[3] * g23.y * PEER_INV_SCALE; }
        v2u ow; ow.x = pk2(o[0], o[1]); ow.y = pk2(o[2], o[3]);
        *(GAS v2u*)(ACT + i) = ow;
    }
}
__device__ __forceinline__ void peer_v_meta(PeerVTok& M, const bf16* ACT, const unsigned short* EXP, int t, int g8) {
#pragma unroll
    for (int k = 0; k < 2; ++k) { M.av[k] = *(const GAS v4u*)(ACT + (size_t)t * 128 + 16 * g8 + 8 * k); M.ev[k] = *(const GAS v4u*)(EXP + (size_t)t * 128 + 16 * g8 + 8 * k); }
}
__device__ __forceinline__ void peer_v_rows(PeerRows& R, peer_rsrc_t rs, unsigned c16, const PeerVTok& M) {
#pragma unroll
    for (int k = 0; k < 16; ++k) R.r[k] = peer_ld_row(rs, peer_id(M.ev, k), c16);
}
__device__ __forceinline__ void peer_v_token(const PeerRows& R, const PeerVTok& M, f32x2 hres, float* op, bool b5, bool b4, bool b3) {
    f32x2 o[8];
#pragma unroll
    for (int p = 0; p < 8; ++p) o[p] = (f32x2){0.f, 0.f};
#pragma unroll
    for (int k = 0; k < 16; ++k) { const unsigned aw = M.av[k >> 3][(k >> 1) & 3]; const float a = (k & 1) ? bhi(aw) : blo(aw); const f32x2 aa = {a, a};
#pragma unroll
        for (int dw = 0; dw < 4; ++dw) {
            o[2 * dw] = __builtin_elementwise_fma(__builtin_amdgcn_cvt_pk_f32_fp8((int)R.r[k][dw], false), aa, o[2 * dw]);
            o[2 * dw + 1] = __builtin_elementwise_fma(__builtin_amdgcn_cvt_pk_f32_fp8((int)R.r[k][dw], true), aa, o[2 * dw + 1]); } }
    f32x2 q4[4], q2[2], q1;
#pragma unroll
    for (int i = 0; i < 4; ++i) { const f32x2 send = b5 ? o[i] : o[i + 4], keep = b5 ? o[i + 4] : o[i];
        q4[i] = (f32x2){keep.x + __shfl_xor(send.x, 32), keep.y + __shfl_xor(send.y, 32)}; }
#pragma unroll
    for (int i = 0; i < 2; ++i) { const f32x2 send = b4 ? q4[i] : q4[i + 2], keep = b4 ? q4[i + 2] : q4[i];
        q2[i] = (f32x2){keep.x + __shfl_xor(send.x, 16), keep.y + __shfl_xor(send.y, 16)}; }
    { const f32x2 send = b3 ? q2[0] : q2[1], keep = b3 ? q2[1] : q2[0]; q1 = (f32x2){keep.x + __shfl_xor(send.x, 8), keep.y + __shfl_xor(send.y, 8)}; }
    __builtin_nontemporal_store(hres + q1, (GAS f32x2*)op);
}
__device__ __forceinline__ void peer_v_phase(Frame& F, float* outp) {
    const int lane = F.lane, w = F.wave, g8 = lane >> 3, c = lane & 7;
    const int x = blockIdx.x & 7, nj = F.G >> 3, j = blockIdx.x >> 3, tpw = T / nj;
    const peer_rsrc_t Vs = __builtin_amdgcn_make_buffer_rsrc((void*)(F.ws + WS_V8 + (size_t)x * NEXP * 128), (short)0, NEXP * 128, 0x00020000); const unsigned c16 = 16u * (unsigned)c;
    const unsigned short* EXP = (const unsigned short*)(F.ws + WS_EXP); const bf16* ACT = (const bf16*)(F.ws + WS_ACT); const bf16* H1B = (const bf16*)(F.ws + WS_R1);
    const bool b5 = lane & 32, b4 = lane & 16, b3 = lane & 8;
    const int col = 128 * x + 16 * c + 8 * (b5 ? 1 : 0) + 4 * (b4 ? 1 : 0) + 2 * (b3 ? 1 : 0);
    const int nold = (tpw * 5) / 8, STR = 4;
    const int t0 = j * tpw + ((w < 4) ? w : nold + (w - 4)), tend = j * tpw + ((w < 4) ? nold : tpw);
    if (t0 >= tend) return;
    PeerVTok MA, MB; PeerRows RA, RB;
    peer_v_meta(MA, ACT, EXP, t0, g8); peer_v_rows(RA, Vs, c16, MA);
    { const int t1 = (t0 + STR < tend) ? t0 + STR : t0; peer_v_meta(MB, ACT, EXP, t1, g8); }
#pragma unroll 1
    for (int t = t0; t < tend; t += 2 * STR) {
        const int tb = (t + STR < tend) ? t + STR : t, tc = (t + 2 * STR < tend) ? t + 2 * STR : t, td = (t + 3 * STR < tend) ? t + 3 * STR : t;
        const unsigned hwa = __builtin_nontemporal_load((const GAS unsigned*)(H1B + (size_t)t * 1024 + col)), hwb = __builtin_nontemporal_load((const GAS unsigned*)(H1B + (size_t)tb * 1024 + col));
        const f32x2 ha = {blo(hwa), bhi(hwa)}, hb2 = {blo(hwb), bhi(hwb)};
        peer_v_rows(RB, Vs, c16, MB);
        peer_v_token(RA, MA, ha, outp + (size_t)t * 1024 + col, b5, b4, b3);
        peer_v_meta(MA, ACT, EXP, tc, g8); peer_v_rows(RA, Vs, c16, MA);
        if (t + STR < tend) peer_v_token(RB, MB, hb2, outp + (size_t)tb * 1024 + col, b5, b4, b3);
        peer_v_meta(MB, ACT, EXP, td, g8);
    }
}
struct Args { const float* in[25]; float* out; unsigned char* ws; int ph_lo, ph_hi, li, pad; };
enum { PH_P0 = 0, PH_GEMM1, PH_S5, PH_GLU, PH_BR1, PH_BR2, PH_OUT, PH_QP, PH_PEER_U, PH_PEER_C, PH_PEER_V, PH_COUNT };

__global__ void __launch_bounds__(NWAVES * 64, 2) mega_fwd(Args args) {
    extern __shared__ __attribute__((aligned(16))) unsigned char lds[];
    Frame F;
    F.lds = (LAS unsigned char*)lds;
    F.MISC = (volatile LAS unsigned*)(F.lds + MISC_OFF);
    F.tid = threadIdx.x; F.lane = F.tid & 63; F.wave = __builtin_amdgcn_readfirstlane(F.tid >> 6);
    F.G = gridDim.x; { const int bx = blockIdx.x; F.vcu = (F.G % 8 == 0) ? (bx % 8) * (F.G / 8) + bx / 8 : bx; }
    F.ws = args.ws; F.out = args.out; F.ctl = (gu32*)(args.ws + WS_CTL);
#pragma unroll
    for (int i = 0; i < 25; ++i) F.in[i] = args.in[i];
    for (int u = F.tid; u < (LDS_BYTES - LDSCTL_OFF) / 4; u += NWAVES * 64) ((LAS unsigned*)(F.lds + LDSCTL_OFF))[u] = 0u;
    __syncthreads();
    XcdBarrier bar = xcd_barrier_post((unsigned*)(F.ctl + CW_BAR) + args.li * XCD_BAR_WORDS, F.MISC + 8);
    const int lo = args.ph_lo, hi = args.ph_hi;
#ifndef PROBE_P0MASK
#define PROBE_P0MASK 15
#endif
#ifndef PROBE_S5VAR
#define PROBE_S5VAR 0
#endif
#ifndef PROBE_ATVAR
#define PROBE_ATVAR 0
#endif
#ifndef PROBE_REP
#define PROBE_REP -1
#endif
#define IN(k) (lo <= (k) && (k) < hi)
#define REPS(k) for (int rep_ = 0; rep_ < ((PROBE_REP == (k)) ? 2 : 1); ++rep_, (void)((PROBE_REP == (k) && rep_ == 1) ? (xcd_barrier(bar), 0) : 0))
#define SEAM(k) do { if (IN(k) && IN((k) + 1)) xcd_barrier(bar); } while (0)
    unsigned char* ws = F.ws;
    bf16* XB = (bf16*)(ws + WS_R1); bf16* ATT = XB; bf16* XN2 = XB;
    bf16* U5 = (bf16*)(ws + WS_U5); bf16* Qb = (bf16*)(ws + WS_Q); bf16* Kb = (bf16*)(ws + WS_K); bf16* Vb = (bf16*)(ws + WS_V);
    bf16* Gt = (bf16*)F.out;
    bf16* YS5 = (bf16*)(ws + WS_YS5); bf16* S5Gb = (bf16*)(ws + WS_S5G); bf16* MIX = (bf16*)(ws + WS_MIX); bf16* QP = (bf16*)(ws + WS_QP);

    if (IN(PH_P0)) REPS(PH_P0) { p0_prologue(F, rep_ ? PROBE_P0MASK : 15); VM_WAIT(); __syncthreads(); } SEAM(PH_P0);

    if (IN(PH_GEMM1)) REPS(PH_GEMM1) {
        pg8::Gemm g{XB, (const bf16*)(ws + WS_W1T), T, INW, D}; pg8::StaticOrder S; S.init(T, INW, F.G, (int)blockIdx.x);
        pg8::EpiProj E{U5, Qb, Kb, Vb, Gt, F.in[I_BGATE]};
        pg8::gemm_phase<pg8::EpiProj, pg8::StaticOrder, false, true>(F.lds, g, S, E);
    }
    ConvPipe CP;
    if (IN(PH_S5)) { conv_init(F, CP); conv_issue(F, CP, 0); }
    SEAM(PH_GEMM1);

    if (IN(PH_S5)) REPS(PH_S5) { mixers_phase(F, CP); }

    if (IN(PH_GLU)) REPS(PH_GLU) {
        pg8::Gemm g{YS5, (const bf16*)(ws + WS_WGLUT), T, 1024, 512}; pg8::StaticOrder S; S.init(T, 1024, F.G, (int)blockIdx.x);
        pg8::EpiGlu E{S5Gb};
        pg8::gemm_phase<pg8::EpiGlu, pg8::StaticOrder, true, true>(F.lds, g, S, E);
    } SEAM(PH_GLU);

    if (IN(PH_BR2)) REPS(PH_BR2) {
        pg8::Gemm g{S5Gb, (const bf16*)(ws + WS_WS5T), T, 1024, 1536, ATT, 512}; pg8::StaticOrder S; S.init(T, 1024, F.G, (int)blockIdx.x);
        pg8::EpiGateDual E{MIX, 1024, Gt};
        pg8::gemm_phase<pg8::EpiGateDual, pg8::StaticOrder, true, true, true>(F.lds, g, S, E);
    } SEAM(PH_BR2);

    if (IN(PH_OUT)) REPS(PH_OUT) {
        pg8::Gemm g{MIX, (const bf16*)(ws + WS_WOUT), T, 1024, 1024}; pg8::StaticOrder S; S.init(T, 1024, F.G, (int)blockIdx.x);
        pg8::EpiRes E{F.in[I_X], F.out, XN2, (float*)(ws + WS_SSQ)};
        pg8::gemm_phase<pg8::EpiRes, pg8::StaticOrder, true, true>(F.lds, g, S, E);
    } SEAM(PH_OUT);

    if (IN(PH_QP)) REPS(PH_QP) {
        pg8::Gemm g{XN2, (const bf16*)(ws + WS_WQT), T, 1024, 1024}; pg8::StaticOrder S; S.init(T, 1024, F.G, (int)blockIdx.x);
        LAS float* rrow = (LAS float*)(F.lds + RROW_OFF);
        { pg8::Unit u0; if (S.next(0, u0) && F.tid < 256) { const int row = u0.pm * 256 + F.tid; const float* sp = (const float*)(ws + WS_SSQ) + (size_t)row * 16;
            const f32x4 a0 = *(const GAS f32x4*)sp, a1 = *(const GAS f32x4*)(sp + 4), a2 = *(const GAS f32x4*)(sp + 8), a3 = *(const GAS f32x4*)(sp + 12);
            const float ssum = ((a0[0] + a0[1]) + (a0[2] + a0[3])) + ((a1[0] + a1[1]) + (a1[2] + a1[3])) + ((a2[0] + a2[1]) + (a2[2] + a2[3])) + ((a3[0] + a3[1]) + (a3[2] + a3[3]));
            const float r = rsqrtf(ssum * (1.0f / D) + RMS_EPS); rrow[F.tid] = r; if (u0.pn == 0) ((float*)(ws + WS_RROW))[row] = r; } }
        LDS_WAIT(); __syncthreads();
        pg8::EpiRowScale E{QP, 1024, rrow};
        pg8::gemm_phase<pg8::EpiRowScale, pg8::StaticOrder, true, true>(F.lds, g, S, E);
        VM_WAIT(); __syncthreads();
        pg8::Unit u; for (int i = 0; S.next(i, u); ++i) topk_unit(F, u.pm, u.pn);
    } SEAM(PH_QP);

    #ifndef PROBE_UVAR
#define PROBE_UVAR 0
#endif
    if (IN(PH_PEER_U)) REPS(PH_PEER_U) { peer_u_phase(F); } SEAM(PH_PEER_U);
    if (IN(PH_PEER_C)) REPS(PH_PEER_C) { peer_combine_phase(F); } SEAM(PH_PEER_C);
    if (IN(PH_PEER_V)) REPS(PH_PEER_V) { peer_v_phase(F, rep_ ? (float*)(ws + WS_P) : F.out); }
#undef IN
#undef SEAM
}
static void launch_mega(Args a, int lo, int hi, int li, int grid, hipStream_t stream) {
    a.ph_lo = lo; a.ph_hi = hi; a.li = li; a.pad = 0;
    hipLaunchKernelGGL(mega_fwd, dim3(grid), dim3(NWAVES * 64), LDS_BYTES, stream, a);
}
extern "C" void kernel_launch(void* const* d_in, const int* in_sizes, int n_in, void* d_out, int out_size, void* d_ws, size_t ws_size, hipStream_t stream) {
    static int grid = 0;
    if (grid == 0) {
        if (n_in != 25 || out_size != T * D || ws_size < WS_END) { fprintf(stderr, "kernel_launch: unexpected shapes n_in %d out %d ws %zu\n", n_in, out_size, ws_size); grid = -1; return; }
        int dev = 0, cus = 0, per_cu = 0;
        if (hipGetDevice(&dev) != hipSuccess || hipDeviceGetAttribute(&cus, hipDeviceAttributeMultiprocessorCount, dev) != hipSuccess) { grid = -1; return; }
        if (hipFuncSetAttribute((const void*)mega_fwd, hipFuncAttributeMaxDynamicSharedMemorySize, LDS_BYTES) != hipSuccess) { fprintf(stderr, "kernel_launch: hipFuncSetAttribute failed\n"); grid = -1; return; }
        if (hipOccupancyMaxActiveBlocksPerMultiprocessor(&per_cu, (const void*)mega_fwd, NWAVES * 64, LDS_BYTES) != hipSuccess || per_cu < 1) { fprintf(stderr, "kernel_launch: occupancy query says %d\n", per_cu); grid = -1; (void)hipGetLastError(); return; }
        if (cus != 256) { fprintf(stderr, "kernel_launch: built for a 256-CU device (one 256x256 GEMM unit per workgroup in the N = 1024 phases), found %d CUs\n", cus); grid = -1; return; }
        grid = cus;
    }
    if (grid < 0) return;
    if (hipMemsetAsync((char*)d_ws + WS_CTL, 0, CTL_ZERO_BYTES, stream) != hipSuccess) { fprintf(stderr, "kernel_launch: memset failed\n"); return; }
    Args a{};
    for (int i = 0; i < 25; ++i) a.in[i] = (const float*)d_in[i];
    a.out = (float*)d_out; a.ws = (unsigned char*)d_ws;
    launch_mega(a, PH_P0, PH_COUNT, 0, grid, stream);
}
```

```cpp
#include <hip/hip_runtime.h>
#include <cstdio>
#include <cstdint>
#include <cmath>

typedef unsigned short bf16;
constexpr int D = 1024, BATCH = 8, SEQ = 2048, T = BATCH * SEQ;
constexpr int S5W = 512, S5C = 16, S5NG = 32, S5P = 64;
constexpr int NQH = 16, NKV = 4, HD = 64, WIN = 128, NBUCK = 32;
constexpr int QW = 1024, KVW = 256, GATEW = 2048, INW = 4096;
constexpr int PH = 8, NSUB = 128, NEXP = 16384, TOPK = 16;
constexpr float RMS_EPS = 1e-6f;

__device__ __forceinline__ unsigned f2bf(float f) { unsigned u = __builtin_bit_cast(unsigned, f); return (u + 0x7fffu + ((u >> 16) & 1u)) >> 16; }
__device__ __forceinline__ float bf2f(unsigned h) { return __builtin_bit_cast(float, h << 16); }
__device__ __forceinline__ float wave_sum(float v) {
#pragma unroll
    for (int o = 1; o < 64; o <<= 1) v += __shfl_xor(v, o);
    return v;
}
__device__ __forceinline__ float wave_max(float v) {
#pragma unroll
    for (int o = 1; o < 64; o <<= 1) v = fmaxf(v, __shfl_xor(v, o));
    return v;
}
__device__ __forceinline__ float gelu_erf(float x) { return 0.5f * x * (1.0f + erff(x * 0.70710678118654752f)); }
__device__ __forceinline__ float sigmoidf_(float x) { return 1.0f / (1.0f + __expf(-x)); }

constexpr size_t MiB = 1u << 20;
constexpr size_t WS_R1 = 99 * MiB;
constexpr size_t WS_U5 = 131 * MiB;
constexpr size_t WS_Q = 147 * MiB;
constexpr size_t WS_K = 179 * MiB;
constexpr size_t WS_V = 187 * MiB;
constexpr size_t WS_S5G = 131 * MiB;
constexpr size_t WS_MIX = 147 * MiB;
constexpr size_t WS_QP = 147 * MiB;
constexpr size_t WS_EXP = 131 * MiB;
constexpr size_t WS_GATE = 139 * MiB;
constexpr size_t WS_YS5 = 195 * MiB;
constexpr size_t WS_END = 211 * MiB;

namespace pg8 {
#define PG8_LAS __attribute__((address_space(3)))
typedef unsigned short bf16_t;
typedef short bf16x8 __attribute__((ext_vector_type(8)));
typedef float f32x4 __attribute__((ext_vector_type(4)));
typedef unsigned u32x4 __attribute__((ext_vector_type(4)));
constexpr int BM = 256, BK = 64, HALF = 128, HTB = HALF * BK * 2  , STAGE_BYTES = 8 * HTB, NXCD = 8, WGM = 8;

__host__ __device__ __forceinline__ int lds_byte(int r, int c) { const int st = (r >> 4) * 2 + (c >> 5), rr = r & 15, cc = c & 31, ob = rr * 64 + cc * 2; return st * 1024 + (ob ^ (((ob >> 9) & 1) << 5)); }
__host__ __device__ __forceinline__ void stage_rc(int b, int& R, int& C) { const int st = b / 1024, sb = b % 1024, swz = sb ^ (((sb >> 9) & 1) << 5); R = (st >> 1) * 16 + swz / 64; C = (st & 1) * 32 + (swz % 64) / 2; }
__host__ __device__ __forceinline__ int perm32(int rho) { const int n = rho >> 4, i = rho & 15; return 8 * (i >> 2) + 4 * n + (i & 3); }

struct Unit { int pm, pn; };
struct Gemm { const bf16_t* A; const bf16_t* Bt; int M, N, K; const bf16_t* A2 = nullptr; int K1 = 0; };

struct StaticOrder {
    int nM, nN, nwg, G, c;
    __host__ __device__ void init(int M, int N, int G_, int c_) { nM = M / BM; nN = N / BM; nwg = nM * nN; G = G_; c = c_; }
    __host__ __device__ bool next(int i, Unit& u) const {
        const long L = (long)i * G + c; if (L >= nwg) return false;
        int wgid = (int)L; { const int q = nwg / NXCD, r = nwg % NXCD, xcd = wgid % NXCD, off = wgid / NXCD; wgid = (xcd < r ? xcd * (q + 1) : r * (q + 1) + (xcd - r) * q) + off; }
        const int nig = WGM * nN, gid = wgid / nig, fm = gid * WGM, gsz = (nM - fm) < WGM ? (nM - fm) : WGM;
        u.pm = fm + ((wgid % nig) % gsz); u.pn = (wgid % nig) / gsz; return true;
    }
    __device__ __forceinline__ void a_ready(const Unit&) const {}
    __device__ __forceinline__ void done(const Unit&) const {}
};

__device__ __forceinline__ unsigned cvt_pk_bf16(float lo, float hi) { unsigned r; asm volatile("v_cvt_pk_bf16_f32 %0, %1, %2" : "=v"(r) : "v"(lo), "v"(hi)); return r; }
__device__ __forceinline__ float bflo(unsigned w) { return __builtin_bit_cast(float, w << 16); }
__device__ __forceinline__ float bfhi(unsigned w) { return __builtin_bit_cast(float, w & 0xffff0000u); }
__device__ __forceinline__ float sigm(float x) { return __builtin_amdgcn_rcpf(1.0f + __expf(-x)); }
__device__ __forceinline__ f32x4 sigm4(f32x4 v) { return (f32x4){sigm(v[0]), sigm(v[1]), sigm(v[2]), sigm(v[3])}; }
__device__ __forceinline__ u32x4 pack8(f32x4 v0, f32x4 v1) { u32x4 w; w.x = cvt_pk_bf16(v0[0], v0[1]); w.y = cvt_pk_bf16(v0[2], v0[3]); w.z = cvt_pk_bf16(v1[0], v1[1]); w.w = cvt_pk_bf16(v1[2], v1[3]); return w; }
__device__ __forceinline__ void unpack8(u32x4 w, f32x4& v0, f32x4& v1) { v0 = (f32x4){bflo(w.x), bfhi(w.x), bflo(w.y), bfhi(w.y)}; v1 = (f32x4){bflo(w.z), bfhi(w.z), bflo(w.w), bfhi(w.w)}; }

struct EpiProj {
    static constexpr bool PERM = true, AFTER_DRAIN = false;
    bf16_t *U5, *Q, *K, *V, *G; const float* bgate;
    __device__ __forceinline__ void operator()(const f32x4 (&acc)[2][2][4][2], const Unit& u, int wr, int wc, int fr, int fq) const {
        const int pn = u.pn; bf16_t* base; int ldc, colt; const bool gate = pn >= 8;
        if (pn < 2) { base = U5; ldc = 512; colt = pn * 256; }
        else if (pn < 6) { base = Q; ldc = 1024; colt = (pn - 2) * 256; }
        else if (pn == 6) { base = K; ldc = 256; colt = 0; }
        else if (pn == 7) { base = V; ldc = 256; colt = 0; }
        else { base = G; ldc = 2048; colt = (pn - 8) * 256; }
        const int row0 = u.pm * BM + wr * 64 + fr, col0 = colt + wc * 32 + 8 * fq;
        f32x4 bv[2][2];
#pragma unroll
        for (int bj = 0; bj < 2; ++bj)
#pragma unroll
            for (int n = 0; n < 2; ++n) bv[bj][n] = gate ? *(const f32x4*)(bgate + col0 + bj * HALF + 4 * n) : (f32x4){0.f, 0.f, 0.f, 0.f};
#pragma unroll
        for (int ai = 0; ai < 2; ++ai)
#pragma unroll
            for (int m = 0; m < 4; ++m) { bf16_t* rowp = base + (size_t)(row0 + ai * HALF + m * 16) * ldc + col0;
#pragma unroll
                for (int bj = 0; bj < 2; ++bj) { f32x4 v0 = acc[ai][bj][m][0] + bv[bj][0], v1 = acc[ai][bj][m][1] + bv[bj][1];
                    if (gate) { v0 = sigm4(v0); v1 = sigm4(v1); }
                    if (pn < 2) {
                        const int r = row0 + ai * HALF + m * 16, cc = col0 + bj * HALF;
                        *(u32x4*)(U5 + ((size_t)((r >> 11) * 32 + (cc >> 4)) * 2048 + (r & 2047)) * 16 + (cc & 15)) = pack8(v0, v1);
                    } else *(u32x4*)(rowp + bj * HALF) = pack8(v0, v1); } }
    }
};
struct EpiGlu {
    static constexpr bool PERM = true, AFTER_DRAIN = false;
    bf16_t* O;
    __device__ __forceinline__ void operator()(const f32x4 (&acc)[2][2][4][2], const Unit& u, int wr, int wc, int fr, int fq) const {
        const int row0 = u.pm * BM + wr * 64 + fr, col0 = u.pn * 128 + wc * 32 + 8 * fq;
#pragma unroll
        for (int ai = 0; ai < 2; ++ai)
#pragma unroll
            for (int m = 0; m < 4; ++m) { bf16_t* rowp = O + (size_t)(row0 + ai * HALF + m * 16) * 512 + col0;
                const f32x4 v0 = acc[ai][0][m][0] * sigm4(acc[ai][1][m][0]), v1 = acc[ai][0][m][1] * sigm4(acc[ai][1][m][1]);
                *(u32x4*)rowp = pack8(v0, v1); }
    }
};
template <int MODE> struct EpiGate {
    static constexpr bool PERM = true, AFTER_DRAIN = false;
    bf16_t* O; int ldc; const bf16_t* G; int goff;
    __device__ __forceinline__ void operator()(const f32x4 (&acc)[2][2][4][2], const Unit& u, int wr, int wc, int fr, int fq) const {
        const int row0 = u.pm * BM + wr * 64 + fr, col0 = u.pn * BM + wc * 32 + 8 * fq;
#pragma unroll
        for (int ai = 0; ai < 2; ++ai)
#pragma unroll
            for (int m = 0; m < 4; ++m) { const size_t row = (size_t)(row0 + ai * HALF + m * 16); bf16_t* rowp = O + row * ldc + col0;
#pragma unroll
                for (int bj = 0; bj < 2; ++bj) { f32x4 v0 = acc[ai][bj][m][0], v1 = acc[ai][bj][m][1];
                    if (MODE >= 1) { f32x4 g0, g1; unpack8(*(const u32x4*)(G + row * 2048 + goff + col0 + bj * HALF), g0, g1); v0 = v0 * g0; v1 = v1 * g1; }
                    if (MODE == 2) { f32x4 t0, t1; unpack8(*(const u32x4*)(rowp + bj * HALF), t0, t1); v0 = v0 + t0; v1 = v1 + t1; }
                    *(u32x4*)(rowp + bj * HALF) = pack8(v0, v1); } }
    }
};
struct EpiGateDual {
    static constexpr bool PERM = true, AFTER_DRAIN = false;
    bf16_t* O; int ldc; const bf16_t* G;
    static __device__ __forceinline__ f32x4 lowc(f32x4 g) { return (f32x4){fmaxf(g[0], 0x1p-60f), fmaxf(g[1], 0x1p-60f), fmaxf(g[2], 0x1p-60f), fmaxf(g[3], 0x1p-60f)}; }
    static __device__ __forceinline__ f32x4 rcp4(f32x4 g) { return (f32x4){__builtin_amdgcn_rcpf(g[0]), __builtin_amdgcn_rcpf(g[1]), __builtin_amdgcn_rcpf(g[2]), __builtin_amdgcn_rcpf(g[3])}; }
    __device__ __forceinline__ void mid(f32x4 (&acc)[2][2][4][2], const Unit& u, int wr, int wc, int fr, int fq) const {
        const int row0 = u.pm * BM + wr * 64 + fr, col0 = u.pn * BM + wc * 32 + 8 * fq;
#pragma unroll
        for (int ai = 0; ai < 2; ++ai)
#pragma unroll
            for (int m = 0; m < 4; ++m) { const size_t row = (size_t)(row0 + ai * HALF + m * 16);
#pragma unroll
                for (int bj = 0; bj < 2; ++bj) { f32x4 a0, a1, b0, b1;
                    unpack8(*(const u32x4*)(G + row * 2048 + col0 + bj * HALF), a0, a1); unpack8(*(const u32x4*)(G + row * 2048 + 1024 + col0 + bj * HALF), b0, b1);
                    acc[ai][bj][m][0] = acc[ai][bj][m][0] * (a0 * rcp4(lowc(b0))); acc[ai][bj][m][1] = acc[ai][bj][m][1] * (a1 * rcp4(lowc(b1))); } }
    }
    __device__ __forceinline__ void operator()(const f32x4 (&acc)[2][2][4][2], const Unit& u, int wr, int wc, int fr, int fq) const {
        const int row0 = u.pm * BM + wr * 64 + fr, col0 = u.pn * BM + wc * 32 + 8 * fq;
#pragma unroll
        for (int ai = 0; ai < 2; ++ai)
#pragma unroll
            for (int m = 0; m < 4; ++m) { const size_t row = (size_t)(row0 + ai * HALF + m * 16); bf16_t* rowp = O + row * ldc + col0;
#pragma unroll
                for (int bj = 0; bj < 2; ++bj) { f32x4 b0, b1; unpack8(*(const u32x4*)(G + row * 2048 + 1024 + col0 + bj * HALF), b0, b1);
                    *(u32x4*)(rowp + bj * HALF) = pack8(acc[ai][bj][m][0] * lowc(b0), acc[ai][bj][m][1] * lowc(b1)); } }
    }
};
struct EpiRes {
    static constexpr bool PERM = true, AFTER_DRAIN = false;
    const float* base; float* out; bf16_t* hb; float* ssq;
    __device__ __forceinline__ void operator()(const f32x4 (&acc)[2][2][4][2], const Unit& u, int wr, int wc, int fr, int fq) const {
        const int row0 = u.pm * BM + wr * 64 + fr, col0 = u.pn * BM + wc * 32 + 8 * fq;
#pragma unroll
        for (int ai = 0; ai < 2; ++ai)
#pragma unroll
            for (int m = 0; m < 4; ++m) { const size_t row = (size_t)(row0 + ai * HALF + m * 16), off = row * 1024 + col0; float ss = 0.f;
#pragma unroll
                for (int bj = 0; bj < 2; ++bj) {
                    const f32x4 b0 = __builtin_nontemporal_load((const f32x4*)(base + off + bj * HALF)), b1 = __builtin_nontemporal_load((const f32x4*)(base + off + bj * HALF + 4));
                    const f32x4 h0 = b0 + acc[ai][bj][m][0], h1 = b1 + acc[ai][bj][m][1];
                    *(u32x4*)(hb + off + bj * HALF) = pack8(h0, h1);
                    ss += (h0[0] * h0[0] + h0[1] * h0[1]) + (h0[2] * h0[2] + h0[3] * h0[3]) + (h1[0] * h1[0] + h1[1] * h1[1]) + (h1[2] * h1[2] + h1[3] * h1[3]); }
                ss += __shfl_xor(ss, 16); ss += __shfl_xor(ss, 32);
                if (fq == 0) ssq[row * 16 + u.pn * 4 + wc] = ss; }
    }
};
struct EpiRowScale {
    static constexpr bool PERM = true, AFTER_DRAIN = false;
    bf16_t* O; int ldc; const PG8_LAS float* rrow;
    __device__ __forceinline__ void operator()(const f32x4 (&acc)[2][2][4][2], const Unit& u, int wr, int wc, int fr, int fq) const {
        const int row0 = u.pm * BM + wr * 64 + fr, col0 = u.pn * BM + wc * 32 + 8 * fq;
#pragma unroll
        for (int ai = 0; ai < 2; ++ai)
#pragma unroll
            for (int m = 0; m < 4; ++m) { const int rl = wr * 64 + fr + ai * HALF + m * 16; const float r = rrow[rl]; bf16_t* rowp = O + (size_t)(u.pm * BM + rl) * ldc + col0;
#pragma unroll
                for (int bj = 0; bj < 2; ++bj) *(u32x4*)(rowp + bj * HALF) = pack8(acc[ai][bj][m][0] * r, acc[ai][bj][m][1] * r); }
    }
};
template <class Epi, class Sched, bool ALIGN_EPI = false, bool SP2 = false, bool DUAL = false>
__device__ __forceinline__ void gemm_phase(PG8_LAS unsigned char* lds, const Gemm g, const Sched& S, const Epi& E) {
    const int tid = threadIdx.x, wid = __builtin_amdgcn_readfirstlane(tid >> 6), lane = tid & 63, wr = wid >> 2, wc = wid & 3, fr = lane & 15, fq = lane >> 4;
    static_assert(!DUAL || SP2, "DUAL is written for the SP2 loop");
    const int K = g.K, nt = K / BK, KA = DUAL ? g.K1 : K, KA2 = K - KA, nt1 = KA / BK;
    unsigned voffA[2], voffB[2], voffA2[2];
#pragma unroll
    for (int i = 0; i < 2; ++i) { int R, C; stage_rc(tid * 16 + i * 8192, R, C); const int Rb = Epi::PERM ? ((R & ~31) + perm32(R & 31)) : R;
        voffA[i] = (unsigned)(R * KA + C) * 2u; voffB[i] = (unsigned)(Rb * K + C) * 2u; voffA2[i] = (unsigned)(R * KA2 + C) * 2u; }
    const size_t kstep = (size_t)(BK * 2);
    const size_t hstep = (size_t)HALF * K * 2;
    const size_t tstep = 2 * hstep;
    const size_t hstepA = (size_t)HALF * KA * 2, hstepA2 = (size_t)HALF * KA2 * 2;
    const unsigned ldsw = (unsigned)wid * 1024u;
    const int aoff = lds_byte(wr * 64 + fr, fq * 8), boff = lds_byte(wc * 32 + fr, fq * 8);
#define PG8_SA(b, h) (((b) * 2 + (h)) * HTB)
#define PG8_SB(b, h) ((4 + (b) * 2 + (h)) * HTB)
#define PG8_STAGE(bufoff, gbase, voff) do { _Pragma("unroll") for (int _i = 0; _i < 2; ++_i) \
        __builtin_amdgcn_global_load_lds((const unsigned*)((const char*)(gbase) + (voff)[_i]), (PG8_LAS unsigned*)(lds + (bufoff) + ldsw + _i * 8192), 16, 0, 0); } while (0)
#define PG8_STA(bufoff, optr, tt, h) do { if constexpr (DUAL) { const int _tt = (tt); const bool _s2 = _tt >= nt1; \
        const char* _p = _s2 ? cA2 + (size_t)(_tt - nt1) * kstep + (size_t)(h) * hstepA2 : cA + (size_t)_tt * kstep + (size_t)(h) * hstepA; \
        const unsigned _v[2] = {_s2 ? voffA2[0] : voffA[0], _s2 ? voffA2[1] : voffA[1]}; PG8_STAGE(bufoff, _p, _v); } else { PG8_STAGE(bufoff, optr, voffA); } } while (0)
#define PG8_LDA(dst, b, h) do { _Pragma("unroll") for (int m = 0; m < 4; ++m) _Pragma("unroll") for (int k = 0; k < 2; ++k) dst[m][k] = *(const PG8_LAS bf16x8*)(lds + PG8_SA(b, h) + aoff + m * 2048 + k * 1024); } while (0)
#define PG8_LDB(dst, b, h) do { _Pragma("unroll") for (int n = 0; n < 2; ++n) _Pragma("unroll") for (int k = 0; k < 2; ++k) dst[n][k] = *(const PG8_LAS bf16x8*)(lds + PG8_SB(b, h) + boff + n * 2048 + k * 1024); } while (0)
#define PG8_MMA(ai, bj, At, Bt) do { __builtin_amdgcn_s_setprio(1); _Pragma("unroll") for (int m = 0; m < 4; ++m) _Pragma("unroll") for (int n = 0; n < 2; ++n) _Pragma("unroll") for (int k = 0; k < 2; ++k) \
        acc[ai][bj][m][n] = __builtin_amdgcn_mfma_f32_16x16x32_bf16(Bt[n][k], At[m][k], acc[ai][bj][m][n], 0, 0, 0); __builtin_amdgcn_s_setprio(0); } while (0)
#define PG8_WAIT_V(n) asm volatile("s_waitcnt vmcnt(" #n ")" ::: "memory")
#define PG8_WAIT_L(n) asm volatile("s_waitcnt lgkmcnt(" #n ")" ::: "memory")
#define PG8_BAR __builtin_amdgcn_s_barrier()
#define PG8_SCHED __builtin_amdgcn_sched_barrier(0)
    Unit cur, nxt; int ui = 0;
    if (!S.next(0, cur)) return;
    f32x4 acc[2][2][4][2];
#pragma unroll
    for (int a = 0; a < 2; ++a)
#pragma unroll
        for (int b = 0; b < 2; ++b)
#pragma unroll
            for (int m = 0; m < 4; ++m)
#pragma unroll
                for (int n = 0; n < 2; ++n) acc[a][b][m][n] = (f32x4){0.f, 0.f, 0.f, 0.f};
    bf16x8 At[4][2], B0[2][2], B1[2][2];
    const char* cA = (const char*)g.A + (size_t)cur.pm * (DUAL ? 2 * hstepA : tstep); const char* cB = (const char*)g.Bt + (size_t)cur.pn * tstep;
    const char* cA2 = DUAL ? (const char*)g.A2 + (size_t)cur.pm * 2 * hstepA2 : cA;
    S.a_ready(cur);
    if constexpr (SP2) {
        PG8_STAGE(PG8_SB(0, 0), cB, voffB); PG8_STAGE(PG8_SB(0, 1), cB + hstep, voffB); PG8_STA(PG8_SA(0, 0), cA, 0, 0); PG8_STA(PG8_SA(0, 1), cA + hstep, 0, 1);
        if (wr == 1) PG8_BAR;
        PG8_WAIT_V(2); PG8_BAR;
        PG8_STAGE(PG8_SB(1, 0), cB + kstep, voffB); PG8_STA(PG8_SA(1, 0), cA + kstep, 1, 0); PG8_STAGE(PG8_SB(1, 1), cB + hstep + kstep, voffB);
        PG8_WAIT_V(6); PG8_BAR;
    } else {
        PG8_STAGE(PG8_SB(0, 0), cB, voffB); PG8_STAGE(PG8_SA(0, 0), cA, voffA); PG8_STAGE(PG8_SB(0, 1), cB + hstep, voffB); PG8_STAGE(PG8_SA(0, 1), cA + hstep, voffA);
        if (wr == 1) PG8_BAR;
        PG8_WAIT_V(4); PG8_BAR;
        PG8_STAGE(PG8_SB(1, 0), cB + kstep, voffB); PG8_STAGE(PG8_SA(1, 0), cA + kstep, voffA); PG8_STAGE(PG8_SB(1, 1), cB + hstep + kstep, voffB);
        PG8_WAIT_V(6); PG8_BAR;
    }
    for (;;) {
        const bool has_next = S.next(ui + 1, nxt);
        const char* nA = has_next ? (const char*)g.A + (size_t)nxt.pm * tstep : cA; const char* nB = has_next ? (const char*)g.Bt + (size_t)nxt.pn * tstep : cB;
        for (int t = 0; t < nt; t += 2) {
            const bool last = (t == nt - 2);
            const char* a1 = cA + (size_t)(t + 1) * kstep;
            const char* a2 = last ? nA : cA + (size_t)(t + 2) * kstep; const char* b2 = last ? nB : cB + (size_t)(t + 2) * kstep;
            const char* a3 = a2 + kstep; const char* b3 = b2 + kstep;
            if (last && has_next) S.a_ready(nxt);
            const int tt2 = last ? 0 : t + 2, tt3 = tt2 + 1;
            if constexpr (DUAL) { if (t == nt1) E.mid(acc, cur, wr, wc, fr, fq); }
            if constexpr (SP2) {
            PG8_LDB(B0, 0, 0); PG8_LDB(B1, 0, 1); PG8_SCHED; PG8_LDA(At, 0, 0); PG8_STA(PG8_SA(1, 1), a1 + hstep, t + 1, 1);
            PG8_WAIT_V(8); PG8_WAIT_L(0); PG8_BAR; PG8_MMA(0, 0, At, B0); PG8_MMA(0, 1, At, B1); PG8_BAR; PG8_SCHED;
            PG8_LDA(At, 0, 1); PG8_STAGE(PG8_SB(0, 0), b2, voffB); PG8_STAGE(PG8_SB(0, 1), b2 + hstep, voffB); PG8_STA(PG8_SA(0, 0), a2, tt2, 0);
            PG8_WAIT_V(8); PG8_WAIT_L(0); PG8_BAR; PG8_MMA(1, 0, At, B0); PG8_MMA(1, 1, At, B1); PG8_BAR; PG8_SCHED;
            PG8_LDB(B0, 1, 0); PG8_LDB(B1, 1, 1); PG8_SCHED; PG8_LDA(At, 1, 0); PG8_STA(PG8_SA(0, 1), a2 + hstep, tt2, 1);
            PG8_WAIT_V(8); PG8_WAIT_L(0); PG8_BAR; PG8_MMA(0, 0, At, B0); PG8_MMA(0, 1, At, B1); PG8_BAR; PG8_SCHED;
            PG8_LDA(At, 1, 1); PG8_STAGE(PG8_SB(1, 0), b3, voffB); PG8_STAGE(PG8_SB(1, 1), b3 + hstep, voffB); PG8_STA(PG8_SA(1, 0), a3, tt3, 0);
            PG8_WAIT_V(8); PG8_WAIT_L(0); PG8_BAR; PG8_MMA(1, 0, At, B0); PG8_MMA(1, 1, At, B1); PG8_BAR; PG8_SCHED;
            } else {
            PG8_LDB(B0, 0, 0); PG8_SCHED; PG8_LDA(At, 0, 0); PG8_STAGE(PG8_SA(1, 1), a1 + hstep, voffA);
            PG8_WAIT_L(8); PG8_BAR; PG8_WAIT_L(0); PG8_MMA(0, 0, At, B0); PG8_BAR; PG8_SCHED;
            PG8_LDB(B1, 0, 1); PG8_STAGE(PG8_SB(0, 0), b2, voffB);
            PG8_BAR; PG8_WAIT_L(0); PG8_MMA(0, 1, At, B1); PG8_BAR;
            PG8_LDA(At, 0, 1); PG8_STAGE(PG8_SA(0, 0), a2, voffA);
            PG8_BAR; PG8_WAIT_L(0); PG8_MMA(1, 0, At, B0); PG8_BAR; PG8_SCHED;
            PG8_STAGE(PG8_SB(0, 1), b2 + hstep, voffB);
            PG8_WAIT_V(6); PG8_BAR; PG8_MMA(1, 1, At, B1); PG8_BAR;
            PG8_LDB(B0, 1, 0); PG8_SCHED; PG8_LDA(At, 1, 0); PG8_STAGE(PG8_SA(0, 1), a2 + hstep, voffA);
            PG8_WAIT_L(8); PG8_BAR; PG8_WAIT_L(0); PG8_MMA(0, 0, At, B0); PG8_BAR; PG8_SCHED;
            PG8_LDB(B1, 1, 1); PG8_STAGE(PG8_SB(1, 0), b3, voffB);
            PG8_BAR; PG8_WAIT_L(0); PG8_MMA(0, 1, At, B1); PG8_BAR;
            PG8_LDA(At, 1, 1); PG8_STAGE(PG8_SA(1, 0), a3, voffA);
            PG8_BAR; PG8_WAIT_L(0); PG8_MMA(1, 0, At, B0); PG8_BAR; PG8_SCHED;
            PG8_STAGE(PG8_SB(1, 1), b3 + hstep, voffB);
            PG8_WAIT_V(6); PG8_BAR; PG8_MMA(1, 1, At, B1); PG8_BAR;
            }
        }
        if constexpr (ALIGN_EPI) { if (wr == 0) PG8_BAR; }
        if constexpr (!Epi::AFTER_DRAIN) { E(acc, cur, wr, wc, fr, fq); S.done(cur); }
        if (!has_next) break;
#pragma unroll
        for (int a = 0; a < 2; ++a)
#pragma unroll
            for (int b = 0; b < 2; ++b)
#pragma unroll
                for (int m = 0; m < 4; ++m)
#pragma unroll
                    for (int n = 0; n < 2; ++n) acc[a][b][m][n] = (f32x4){0.f, 0.f, 0.f, 0.f};
        cur = nxt; cA = nA; cB = nB; ++ui;
        if constexpr (ALIGN_EPI) { if (wr == 1) PG8_BAR; }
    }
    PG8_WAIT_V(0);
    if constexpr (!ALIGN_EPI) { if (wr == 0) PG8_BAR; }
    PG8_BAR;
    if constexpr (Epi::AFTER_DRAIN) { E.fused(acc, cur, wr, wc, fr, fq, lds, wid, lane); S.done(cur); }
#undef PG8_SA
#undef PG8_SB
#undef PG8_STAGE
#undef PG8_STA
#undef PG8_LDA
#undef PG8_LDB
#undef PG8_MMA
#undef PG8_WAIT_V
#undef PG8_WAIT_L
#undef PG8_BAR
#undef PG8_SCHED
}
}
constexpr int NWAVES = 8;
constexpr size_t WS_CTL = 0, CTL_ZERO_BYTES = 64 * 1024;
constexpr size_t WS_A64 = 512 * 1024;
constexpr size_t WS_W1T = 1 * MiB;
constexpr size_t WS_WGLUT = 9 * MiB;
constexpr size_t WS_WS5T = 10 * MiB;
constexpr size_t WS_WATT = 11 * MiB;
constexpr size_t WS_WOUT = 13 * MiB;
constexpr size_t WS_WQT = 15 * MiB;
constexpr size_t WS_SKB = 17 * MiB;
constexpr size_t WS_UB = 18 * MiB;
constexpr size_t WS_VB = 50 * MiB;
constexpr size_t WS_KT = 82 * MiB;
constexpr size_t WS_E = 83 * MiB;
constexpr size_t WS_F = 91 * MiB;
static_assert(WS_F + 8 * MiB <= WS_R1, "ws map");
constexpr size_t WS_RROW = 768 * 1024;
constexpr size_t WS_SSQ = 58 * MiB;
constexpr int CW_BAR = 1024;

constexpr int RING_BYTES = 131072;
constexpr int LDSCTL_OFF = 142336, MISC_OFF = LDSCTL_OFF + 320, RROW_OFF = LDSCTL_OFF + 1024;
constexpr int LDS_BYTES = 147456;
#define GAS __attribute__((address_space(1)))
#define LAS __attribute__((address_space(3)))
typedef unsigned v4u __attribute__((ext_vector_type(4)));
typedef unsigned v2u __attribute__((ext_vector_type(2)));
typedef float f32x4 __attribute__((ext_vector_type(4)));
typedef float f32x16 __attribute__((ext_vector_type(16)));
typedef short bf16x8 __attribute__((ext_vector_type(8)));
typedef GAS unsigned gu32;
#define RLX_AGENT __ATOMIC_RELAXED, __HIP_MEMORY_SCOPE_AGENT
#define LDS_WAIT() asm volatile("s_waitcnt lgkmcnt(0)" ::: "memory")
#define VM_WAIT() asm volatile("s_waitcnt vmcnt(0)" ::: "memory")
__device__ __forceinline__ unsigned pk2(float lo, float hi) { return f2bf(lo) | (f2bf(hi) << 16); }
__device__ __forceinline__ unsigned cvtpk(float lo, float hi) { unsigned r; asm volatile("v_cvt_pk_bf16_f32 %0, %1, %2" : "=v"(r) : "v"(lo), "v"(hi)); return r; }
__device__ __forceinline__ float blo(unsigned w) { return __builtin_bit_cast(float, w << 16); }
__device__ __forceinline__ float bhi(unsigned w) { return __builtin_bit_cast(float, w & 0xffff0000u); }
#define XB_TMO      128
#define XB_XCNT(j)  (256  + 64 * (j))
#define XB_XSUB(j)  (1280 + 64 * (j))
#define XB_XGEN(j)  (2304 + 64 * (j))
#define XB_TOP      3328
#define XB_TOPGEN   3392
#define XCD_BAR_WORDS 3456
#define XB_SPIN_CAP (1u << 18)

__device__ __forceinline__ unsigned xb_ld(unsigned* p)              { return __hip_atomic_load(p, __ATOMIC_RELAXED, __HIP_MEMORY_SCOPE_AGENT); }
__device__ __forceinline__ unsigned xb_add(unsigned* p, unsigned v) { return __hip_atomic_fetch_add(p, v, __ATOMIC_RELAXED, __HIP_MEMORY_SCOPE_AGENT); }
__device__ __forceinline__ unsigned xb_xcc_id() { return (unsigned)__builtin_amdgcn_s_getreg((3 << 11) | 20) & 0xFu; }
#define XB_SPIN(cond, bar) do { unsigned _sp = 0; while (cond) { __builtin_amdgcn_s_sleep(1); \
    if ((++_sp & 255u) == 0u) { if (xb_ld(&(bar)[XB_TMO])) break; if (_sp > XB_SPIN_CAP) { atomicAdd(&(bar)[XB_TMO], 1u); break; } } } } while (0)

struct XcdBarrier {
    unsigned* bar; unsigned x;
    volatile LAS unsigned* st;
};

__device__ __forceinline__ XcdBarrier xcd_barrier_post(unsigned* bar, volatile LAS unsigned* st) {
    XcdBarrier b; b.bar = bar; b.x = xb_xcc_id(); b.st = st;
    if (threadIdx.x == 0) (void)xb_add(&bar[XB_XCNT(b.x)], 1u);
    return b;
}
__device__ __forceinline__ void xcd_barrier_complete(unsigned* bar, unsigned x, unsigned& nloc, unsigned& nx) {
    const unsigned G = gridDim.x * gridDim.y * gridDim.z;
    unsigned sum, cnt, mine, sp = 0u;
    for (;;) {
        sum = 0u; cnt = 0u; mine = 0u;
#pragma unroll
        for (unsigned j = 0; j < 16; ++j) { const unsigned c = xb_ld(&bar[XB_XCNT(j)]); sum += c; cnt += (c > 0u) ? 1u : 0u; mine = (j == x) ? c : mine; }
        if (sum == G) break;
        __builtin_amdgcn_s_sleep(1);
        if ((++sp & 255u) == 0u) { if (xb_ld(&bar[XB_TMO])) break; if (sp > XB_SPIN_CAP) { atomicAdd(&bar[XB_TMO], 1u); break; } }
    }
    nloc = mine > 0u ? mine : 1u; nx = cnt > 0u ? cnt : 1u;
}

__device__ __forceinline__ void xcd_barrier(const XcdBarrier& b) {
    asm volatile("s_waitcnt vmcnt(0)" ::: "memory");
    __syncthreads();
    if (threadIdx.x == 0) {
        unsigned* bar = b.bar;
        __builtin_amdgcn_s_waitcnt(0);
        unsigned nloc = b.st[0], nx = b.st[1];
        if (nloc == 0u) { xcd_barrier_complete(bar, b.x, nloc, nx); b.st[0] = nloc; b.st[1] = nx; }
        const unsigned old = xb_add(&bar[XB_XSUB(b.x)], 1u);
        const unsigned gen = old / nloc;
        if (old + 1u == (gen + 1u) * nloc) {
            __builtin_amdgcn_fence(__ATOMIC_RELEASE, "agent");
            asm volatile("s_waitcnt vmcnt(0)" ::: "memory");
            const unsigned og = xb_add(&bar[XB_TOP], 1u);
            const unsigned tg = og / nx;
            if (og + 1u == (tg + 1u) * nx) xb_add(&bar[XB_TOPGEN], 1u);
            else XB_SPIN(xb_ld(&bar[XB_TOPGEN]) == tg, bar);
            __builtin_amdgcn_fence(__ATOMIC_ACQUIRE, "agent");
            xb_add(&bar[XB_XGEN(b.x)], 1u);
            asm volatile("s_waitcnt vmcnt(0)" ::: "memory");
        } else {
            XB_SPIN(xb_ld(&bar[XB_XGEN(b.x)]) == gen, bar);
            __builtin_amdgcn_fence(__ATOMIC_ACQUIRE, "agent");
            asm volatile("s_waitcnt vmcnt(0)" ::: "memory");
        }
    }
    __syncthreads();
}
struct Frame {
    LAS unsigned char* lds;
    volatile LAS unsigned* MISC;
    gu32* ctl;
    int tid, lane, wave, vcu, G;
    const float* in[25]; float* out; unsigned char* ws;
};
enum { I_X = 0, I_LN1, I_WIN, I_BGATE, I_LRE, I_LIM, I_LSTEP, I_BRE, I_BIM, I_CRE, I_CIM, I_S5D, I_WGLU, I_WS5B, I_GQ, I_GK, I_BIAS, I_SINK, I_WATT, I_WOUT, I_LN2, I_WQ, I_SK, I_PU, I_PV };

template <bool GLU>
__device__ __forceinline__ void p0_transpose_item(const float* W, int K, int N, bf16* WT, LAS float* scr, int item, int lane, const float* kscale = nullptr, int ldw = 0) {
    if (ldw == 0) ldw = K;
    const int nblk = N / 32, kb = item / nblk, nb = item % nblk, k0 = 64 * kb, n0 = 32 * nb;
#pragma unroll 8
    for (int i = 0; i < 32; ++i) { const int kk = 2 * i + (lane >> 5); const float sc_ = kscale ? kscale[k0 + kk] : 1.0f; scr[kk * 33 + (lane & 31)] = __builtin_nontemporal_load((const GAS float*)(W + (size_t)(k0 + kk) * N + n0 + (lane & 31))) * sc_; }
    LDS_WAIT(); asm volatile("" ::: "memory");
    const int c = lane & 7;
#pragma unroll
    for (int j = 0; j < 4; ++j) { const int n = (lane >> 3) + 8 * j; const LAS float* s = scr + (8 * c) * 33 + n;
        v4u o; o.x = pk2(s[0 * 33], s[1 * 33]); o.y = pk2(s[2 * 33], s[3 * 33]); o.z = pk2(s[4 * 33], s[5 * 33]); o.w = pk2(s[6 * 33], s[7 * 33]);
        const int nn = n0 + n; const int row = GLU ? (256 * ((nn & 511) >> 7) + 128 * (nn >> 9) + (nn & 127)) : nn;
        *(GAS v4u*)(WT + (size_t)row * ldw + k0 + 8 * c) = o; }
    LDS_WAIT(); asm volatile("" ::: "memory");
}
struct TrDesc { const float* W; bf16* WT; const float* kscale; int K, N, ldw, item; bool glu; };
struct TrRegs { f32x4 v[8]; };
__device__ __forceinline__ void tr_load(const TrDesc& d, TrRegs& R, int lane) {
    const int nblk = d.N / 32, kb = d.item / nblk, nb = d.item % nblk, k0 = 64 * kb, n0 = 32 * nb;
#pragma unroll
    for (int i = 0; i < 8; ++i) R.v[i] = __builtin_nontemporal_load((const GAS f32x4*)(d.W + (size_t)(k0 + 8 * i + (lane >> 3)) * d.N + n0 + 4 * (lane & 7)));
}
__device__ __forceinline__ void tr_finish(const TrDesc& d, const TrRegs& R, LAS float* scr, int lane) {
    const int nblk = d.N / 32, kb = d.item / nblk, nb = d.item % nblk, k0 = 64 * kb, n0 = 32 * nb;
#pragma unroll
    for (int i = 0; i < 8; ++i) { const int kk = 8 * i + (lane >> 3); const float sc_ = d.kscale ? d.kscale[k0 + kk] : 1.0f; LAS float* sp = scr + kk * 33 + 4 * (lane & 7);
        sp[0] = R.v[i][0] * sc_; sp[1] = R.v[i][1] * sc_; sp[2] = R.v[i][2] * sc_; sp[3] = R.v[i][3] * sc_; }
    LDS_WAIT(); asm volatile("" ::: "memory");
    const int c = lane & 7;
#pragma unroll
    for (int j = 0; j < 4; ++j) { const int n = (lane >> 3) + 8 * j; const LAS float* s = scr + (8 * c) * 33 + n;
        v4u o; o.x = pk2(s[0 * 33], s[1 * 33]); o.y = pk2(s[2 * 33], s[3 * 33]); o.z = pk2(s[4 * 33], s[5 * 33]); o.w = pk2(s[6 * 33], s[7 * 33]);
        const int nn = n0 + n; const int row = d.glu ? (256 * ((nn & 511) >> 7) + 128 * (nn >> 9) + (nn & 127)) : nn;
        *(GAS v4u*)(d.WT + (size_t)row * d.ldw + k0 + 8 * c) = o; }
    LDS_WAIT(); asm volatile("" ::: "memory");
}
__device__ __forceinline__ void p0_convert_row(const float* src, bf16* dst, int lane) {
#pragma unroll
    for (int j = 0; j < 2; ++j) { const int c = lane + 64 * j; const f32x4 a = *(const GAS f32x4*)(src + 8 * c), b = *(const GAS f32x4*)(src + 8 * c + 4);
        v4u o; o.x = pk2(a[0], a[1]); o.y = pk2(a[2], a[3]); o.z = pk2(b[0], b[1]); o.w = pk2(b[2], b[3]); *(GAS v4u*)(dst + 8 * c) = o; }
}
template <bool FP8>
__device__ __forceinline__ void rms_row_to_bf16(const float* xrow, const float* g, bf16* orow, int lane, unsigned char* oh = nullptr, unsigned char* ol = nullptr) {
    const GAS f32x4* xr = (const GAS f32x4*)xrow + lane;
    f32x4 v[4]; float s = 0.f;
#pragma unroll
    for (int j = 0; j < 4; ++j) { v[j] = xr[64 * j]; s += (v[j].x * v[j].x + v[j].y * v[j].y) + (v[j].z * v[j].z + v[j].w * v[j].w); }
    s = wave_sum(s);
    const float r = rsqrtf(s * (1.0f / D) + RMS_EPS);
    const GAS f32x4* gr = (const GAS f32x4*)g + lane;
    GAS v2u* o = (GAS v2u*)orow + lane;
#pragma unroll
    for (int j = 0; j < 4; ++j) { const f32x4 gg = gr[64 * j]; const f32x4 y = {v[j].x * r * gg.x, v[j].y * r * gg.y, v[j].z * r * gg.z, v[j].w * r * gg.w};
        v2u w; w.x = pk2(y.x, y.y); w.y = pk2(y.z, y.w); o[64 * j] = w;
        if (FP8) { int h = 0; h = __builtin_amdgcn_cvt_pk_fp8_f32(y.x, y.y, h, false); h = __builtin_amdgcn_cvt_pk_fp8_f32(y.z, y.w, h, true);
            const auto h01 = __builtin_amdgcn_cvt_pk_f32_fp8(h, false), h23 = __builtin_amdgcn_cvt_pk_f32_fp8(h, true);
            int l = 0; l = __builtin_amdgcn_cvt_pk_fp8_f32(y.x - h01[0], y.y - h01[1], l, false); l = __builtin_amdgcn_cvt_pk_fp8_f32(y.z - h23[0], y.w - h23[1], l, true);
            ((GAS int*)oh)[lane + 64 * j] = h; ((GAS int*)ol)[lane + 64 * j] = l; } }
}
template <int NR>
__device__ __forceinline__ void rms_rows_to_bf16(const float* x, size_t row_stride, const float* g, bf16* o, int lane) {
    f32x4 v[NR][4]; float s[NR];
#pragma unroll
    for (int r = 0; r < NR; ++r)
#pragma unroll
        for (int j = 0; j < 4; ++j) v[r][j] = __builtin_nontemporal_load((const GAS f32x4*)(x + r * row_stride) + lane + 64 * j);
#pragma unroll
    for (int r = 0; r < NR; ++r) { s[r] = 0.f;
#pragma unroll
        for (int j = 0; j < 4; ++j) s[r] += (v[r][j].x * v[r][j].x + v[r][j].y * v[r][j].y) + (v[r][j].z * v[r][j].z + v[r][j].w * v[r][j].w); }
#pragma unroll
    for (int of = 1; of < 64; of <<= 1)
#pragma unroll
        for (int r = 0; r < NR; ++r) s[r] += __shfl_xor(s[r], of);
    const GAS f32x4* gr = (const GAS f32x4*)g + lane;
#pragma unroll
    for (int j = 0; j < 4; ++j) { const f32x4 gg = gr[64 * j];
#pragma unroll
        for (int r = 0; r < NR; ++r) { const float rr = rsqrtf(s[r] * (1.0f / D) + RMS_EPS); v2u w;
            w.x = pk2(v[r][j].x * rr * gg.x, v[r][j].y * rr * gg.y); w.y = pk2(v[r][j].z * rr * gg.z, v[r][j].w * rr * gg.w); ((GAS v2u*)(o + r * row_stride) + lane)[64 * j] = w; } }
}
struct XPipe { f32x4 v[4][4]; };
__device__ __forceinline__ void x_issue(XPipe& X, const float* x, size_t row_stride, int lane) {
#pragma unroll
    for (int r = 0; r < 4; ++r)
#pragma unroll
        for (int j = 0; j < 4; ++j) X.v[r][j] = __builtin_nontemporal_load((const GAS f32x4*)(x + r * row_stride) + lane + 64 * j);
}
__device__ __forceinline__ void x_retire(const XPipe& X, size_t row_stride, const float* g, bf16* o, int lane) {
    float s[4];
#pragma unroll
    for (int r = 0; r < 4; ++r) { s[r] = 0.f;
#pragma unroll
        for (int j = 0; j < 4; ++j) s[r] += (X.v[r][j].x * X.v[r][j].x + X.v[r][j].y * X.v[r][j].y) + (X.v[r][j].z * X.v[r][j].z + X.v[r][j].w * X.v[r][j].w); }
#pragma unroll
    for (int of = 1; of < 64; of <<= 1)
#pragma unroll
        for (int r = 0; r < 4; ++r) s[r] += __shfl_xor(s[r], of);
    const GAS f32x4* gr = (const GAS f32x4*)g + lane;
#pragma unroll
    for (int j = 0; j < 4; ++j) { const f32x4 gg = gr[64 * j];
#pragma unroll
        for (int r = 0; r < 4; ++r) { const float rr = rsqrtf(s[r] * (1.0f / D) + RMS_EPS); v2u w;
            w.x = pk2(X.v[r][j].x * rr * gg.x, X.v[r][j].y * rr * gg.y); w.y = pk2(X.v[r][j].z * rr * gg.z, X.v[r][j].w * rr * gg.w); ((GAS v2u*)(o + r * row_stride) + lane)[64 * j] = w; } }
}
struct P0Row { f32x4 v[4]; };
__device__ __forceinline__ void p0_fp8_load(P0Row& R, const float* src, int lane) {
#pragma unroll
    for (int i = 0; i < 4; ++i) R.v[i] = __builtin_nontemporal_load((const GAS f32x4*)(src + 4 * (lane + 64 * i)));
}
__device__ __forceinline__ void p0_fp8_store(const P0Row& R, unsigned char* dst, int e, int lane, const float* cscale = nullptr) {
    const float S = 256.0f;
#pragma unroll
    for (int i = 0; i < 4; ++i) { f32x4 sv = {S, S, S, S}; if (cscale) sv = sv * *(const GAS f32x4*)(cscale + 4 * (lane + 64 * i));
        int w = 0; w = __builtin_amdgcn_cvt_pk_fp8_f32(R.v[i][0] * sv[0], R.v[i][1] * sv[1], w, false); w = __builtin_amdgcn_cvt_pk_fp8_f32(R.v[i][2] * sv[2], R.v[i][3] * sv[3], w, true);
        __builtin_nontemporal_store(w, (GAS int*)(dst + ((size_t)(2 * i + (lane >> 5)) * NEXP + e) * 128 + 4 * (lane & 31))); }
}
__device__ __forceinline__ void p0_s5_tables(Frame& F_, int item, XPipe& X, bool dox) {
    const int g = item >> 3, tb = item & 7, tid = F_.tid;
    LAS float* pwA = (LAS float*)(F_.lds);
    LAS float* pwB = pwA + 1024;
    LAS float* pwC = pwB + 1024;
    LAS float* bbL = pwC + 1024;
    LAS float* fwA = bbL + 2048;
    const float* lam_re = F_.in[I_LRE]; const float* lam_im = F_.in[I_LIM];
    const float st = expf(F_.in[I_LSTEP][g]);
    {
        const int jj = tid >> 6, p = tid & 63, j = 8 * tb + jj;
        const float lr = lam_re[g * 64 + p], li = lam_im[g * 64 + p];
        const float tA = (float)j * st, tB = (float)(j + 1) * st, tC = (float)(63 - j) * st;
        const float mA = __expf(lr * tA), mB = __expf(lr * tB), mC = __expf(lr * tC);
        pwA[tid * 2] = mA * __cosf(li * tA); pwA[tid * 2 + 1] = mA * __sinf(li * tA);
        pwB[tid * 2] = mB * __cosf(li * tB); pwB[tid * 2 + 1] = mB * __sinf(li * tB);
        pwC[tid * 2] = mC * __cosf(li * tC); pwC[tid * 2 + 1] = mC * __sinf(li * tC);
        if (tb == 0 && jj == 0) { const float t64 = 64.0f * st, m64 = expf(lr * t64); float* a64 = (float*)(F_.ws + WS_A64) + (g * 64 + p) * 2; a64[0] = m64 * cosf(li * t64); a64[1] = m64 * sinf(li * t64); }
    }
    for (int idx = tid; idx < 1024; idx += 512) {
        const int p = idx >> 4, c = idx & 15;
        const float lr = lam_re[g * 64 + p], li = lam_im[g * 64 + p];
        const float mag = expf(lr * st), are = mag * cosf(li * st), aim = mag * sinf(li * st);
        const float den = lr * lr + li * li, nr = are - 1.0f, ni = aim;
        const float cfr = (nr * lr + ni * li) / den, cfi = (ni * lr - nr * li) / den;
        const float br = F_.in[I_BRE][(g * 64 + p) * 16 + c], bi = F_.in[I_BIM][(g * 64 + p) * 16 + c];
        bbL[p * 16 + c] = cfr * br - cfi * bi; bbL[(64 + p) * 16 + c] = cfr * bi + cfi * br;
    }
    __syncthreads();
    bf16* Fg = (bf16*)(F_.ws + WS_F) + (size_t)g * 1024 * 128;
    bf16* Eg = (bf16*)(F_.ws + WS_E) + (size_t)g * 128 * 1024;
    bf16* KTg = (bf16*)(F_.ws + WS_KT) + (size_t)g * 64 * 256;
    for (int idx = tid; idx < 2048; idx += 512) {
        const int oct = idx & 15, c = (idx >> 4) & 15, jj = idx >> 8, p0 = 8 * (oct & 7); const bool isim = oct >> 3;
        const f32x4 cr0 = *(const GAS f32x4*)(F_.in[I_CRE] + (g * 16 + c) * 64 + p0), cr1 = *(const GAS f32x4*)(F_.in[I_CRE] + (g * 16 + c) * 64 + p0 + 4);
        const f32x4 ci0 = *(const GAS f32x4*)(F_.in[I_CIM] + (g * 16 + c) * 64 + p0), ci1 = *(const GAS f32x4*)(F_.in[I_CIM] + (g * 16 + c) * 64 + p0 + 4);
        float fB[8], fA[8];
#pragma unroll
        for (int e = 0; e < 8; ++e) { const float cr = e < 4 ? cr0[e & 3] : cr1[e & 3], ci = e < 4 ? ci0[e & 3] : ci1[e & 3];
            const float br_ = pwB[(jj * 64 + p0 + e) * 2], bi_ = pwB[(jj * 64 + p0 + e) * 2 + 1], ar_ = pwA[(jj * 64 + p0 + e) * 2], ai_ = pwA[(jj * 64 + p0 + e) * 2 + 1];
            fB[e] = isim ? -(cr * bi_ + ci * br_) : (cr * br_ - ci * bi_); fA[e] = isim ? -(cr * ai_ + ci * ar_) : (cr * ar_ - ci * ai_); }
        const int j_ = 8 * tb + jj;
        v4u o; o.x = pk2(fB[0], fB[1]); o.y = pk2(fB[2], fB[3]); o.z = pk2(fB[4], fB[5]); o.w = pk2(fB[6], fB[7]);
        *(GAS v4u*)(Fg + ((size_t)(((j_ >> 1) * 8 + (oct >> 1)) * 64 + (oct & 1) * 32 + (j_ & 1) * 16 + c)) * 8) = o;
        LAS float* fw = fwA + (jj * 16 + c) * 128 + 8 * oct;
        *(LAS f32x4*)fw = (f32x4){fA[0], fA[1], fA[2], fA[3]}; *(LAS f32x4*)(fw + 4) = (f32x4){fA[4], fA[5], fA[6], fA[7]};
    }
    if (dox) {
        const int gw = F_.vcu * NWAVES + F_.wave, NGW = F_.G * NWAVES; const size_t rs = (size_t)NGW * D;
        x_retire(X, rs, F_.in[I_LN1], (bf16*)(F_.ws + WS_R1) + (size_t)gw * D, F_.lane);
        x_issue(X, F_.in[I_X] + (size_t)(gw + 4 * NGW) * D, rs, F_.lane);
    }
    for (int idx = tid; idx < 2048; idx += 512) {
        const int co = idx & 1, jj = (idx >> 1) & 7, pp = idx >> 4, p = pp & 63;
        const float pr = pwC[(jj * 64 + p) * 2], pi = pwC[(jj * 64 + p) * 2 + 1];
        const f32x4 br0 = *(const LAS f32x4*)(bbL + p * 16 + 8 * co), br1 = *(const LAS f32x4*)(bbL + p * 16 + 8 * co + 4);
        const f32x4 bi0 = *(const LAS f32x4*)(bbL + (64 + p) * 16 + 8 * co), bi1 = *(const LAS f32x4*)(bbL + (64 + p) * 16 + 8 * co + 4);
        float v[8];
#pragma unroll
        for (int e = 0; e < 8; ++e) { const float br = e < 4 ? br0[e & 3] : br1[e & 3], bi = e < 4 ? bi0[e & 3] : bi1[e & 3]; v[e] = pp < 64 ? (pr * br - pi * bi) : (pr * bi + pi * br); }
        v4u o; o.x = pk2(v[0], v[1]); o.y = pk2(v[2], v[3]); o.z = pk2(v[4], v[5]); o.w = pk2(v[6], v[7]);
        *(GAS v4u*)(Eg + ((size_t)(((pp >> 5) * 64 + (8 * tb + jj)) * 64 + co * 32 + (pp & 31))) * 8) = o;
    }
    __syncthreads();
    {
        const int cq = tid & 3, c = (tid >> 2) & 15, jj = tid >> 6;
        const LAS float* fr = fwA + (jj * 16 + c) * 128; f32x4 s4 = {0.f, 0.f, 0.f, 0.f};
#pragma unroll 8
        for (int pp = 0; pp < 128; ++pp) s4 += fr[pp] * *(const LAS f32x4*)(bbL + pp * 16 + 4 * cq);
        v2u o; o.x = pk2(s4[0], s4[1]); o.y = pk2(s4[2], s4[3]);
        *(GAS v2u*)(KTg + ((8 * tb + jj) * 16 + c) * 16 + 4 * cq) = o;
    }
    __syncthreads();
}
__device__ __forceinline__ void peer_tables_to_fp8(Frame& F) {
    const int gw = F.vcu * NWAVES + F.wave, NGW = F.G * NWAVES;
    for (int m = gw; m < NEXP; m += 4 * NGW) {
        P0Row a[4], b[4];
#pragma unroll
        for (int r = 0; r < 4; ++r) { p0_fp8_load(a[r], F.in[I_PU] + (size_t)(m + r * NGW) * D, F.lane); p0_fp8_load(b[r], F.in[I_PV] + (size_t)(m + r * NGW) * D, F.lane); }
#pragma unroll
        for (int r = 0; r < 4; ++r) { p0_fp8_store(a[r], F.ws + 18 * MiB, m + r * NGW, F.lane, F.in[I_LN2]); p0_fp8_store(b[r], F.ws + 34 * MiB, m + r * NGW, F.lane); }
    }
}
__device__ __forceinline__ void p0_prologue(Frame& F, int mask = 15) {
    const int gw = F.vcu * NWAVES + F.wave, NGW = F.G * NWAVES;
    const bool dox = (mask & 4) != 0, pipe = dox && (mask & 1) && F.vcu < 256 && T == 8 * NGW; const size_t xrs = (size_t)NGW * D;
    XPipe X;
    if (pipe) x_issue(X, F.in[I_X] + (size_t)gw * D, xrs, F.lane);
    if (mask & 1) for (int it = F.vcu; it < 256; it += F.G) p0_s5_tables(F, it, X, pipe && it == F.vcu);
    if (pipe) x_retire(X, xrs, F.in[I_LN1], (bf16*)(F.ws + WS_R1) + (size_t)(gw + 4 * NGW) * D, F.lane);
    LAS float* scr = (LAS float*)(F.lds + F.wave * 16384);
    constexpr int I1 = 16 * 128, I2 = 8 * 32, I3 = 8 * 32, I4 = 16 * 32, I5 = 16 * 32, I6 = 16 * 32, NIT = I1 + I2 + I3 + I4 + I5 + I6;
    if (mask & 2) {
        auto desc = [&](int it) { TrDesc d; int r = it; d.kscale = nullptr; d.glu = false; d.item = 0; d.W = F.in[I_WIN]; d.WT = (bf16*)(F.ws + WS_W1T); d.K = 1024; d.N = 4096; d.ldw = 1024;
            if (r < I1) { d.item = r; return d; } r -= I1;
            if (r < I2) { d.W = F.in[I_WGLU]; d.WT = (bf16*)(F.ws + WS_WGLUT); d.K = 512; d.N = 1024; d.ldw = 512; d.glu = true; d.item = r; return d; } r -= I2;
            if (r < I3) { d.W = F.in[I_WS5B]; d.WT = (bf16*)(F.ws + WS_WS5T); d.K = 512; d.N = 1024; d.ldw = 1536; d.item = r; return d; } r -= I3;
            if (r < I4) { d.W = F.in[I_WATT]; d.WT = (bf16*)(F.ws + WS_WS5T) + 512; d.K = 1024; d.N = 1024; d.ldw = 1536; d.item = r; return d; } r -= I4;
            if (r < I5) { d.W = F.in[I_WOUT]; d.WT = (bf16*)(F.ws + WS_WOUT); d.K = 1024; d.N = 1024; d.ldw = 1024; d.item = r; return d; } r -= I5;
            d.W = F.in[I_WQ]; d.WT = (bf16*)(F.ws + WS_WQT); d.K = 1024; d.N = 1024; d.ldw = 1024; d.kscale = F.in[I_LN2]; d.item = r; return d; };
        int it = gw;
        if (it < NIT) { TrDesc d = desc(it); TrRegs R; tr_load(d, R, F.lane);
#pragma unroll 1
            for (;;) { const int itn = it + NGW; const bool hn = itn < NIT; TrDesc dn = d; TrRegs Rn = R;
                if (hn) { dn = desc(itn); tr_load(dn, Rn, F.lane); }
                tr_finish(d, R, scr, F.lane);
                if (!hn) break;
                it = itn; d = dn; R = Rn; } }
    }
    if (dox && !pipe) for (int m = gw; m < T; m += 4 * NGW) rms_rows_to_bf16<4>(F.in[I_X] + (size_t)m * D, (size_t)NGW * D, F.in[I_LN1], (bf16*)(F.ws + WS_R1) + (size_t)m * D, F.lane);
    for (int m = gw; m < 128; m += NGW) p0_convert_row(F.in[I_SK] + (size_t)m * D, (bf16*)(F.ws + WS_SKB) + (size_t)m * D, F.lane);
}
__device__ __forceinline__ int crow(int r, int hi) { return (r & 3) + 8 * (r >> 2) + 4 * hi; }
#define MFMA32(a, b, c) __builtin_amdgcn_mfma_f32_32x32x16_bf16((a), (b), (c), 0, 0, 0)
typedef LAS const bf16x8* lds_b8p;
__device__ __forceinline__ bf16x8 lds_ld8(LAS unsigned char* base, int off) { return *(LAS const bf16x8*)(base + off); }
__device__ __forceinline__ float gelu_f(float x) { return 0.5f * x * (1.0f + erff(x * 0.70710678118654752f)); }
typedef float f32x2 __attribute__((ext_vector_type(2)));
__device__ __forceinline__ f32x2 gelu_pk(f32x2 v) {
    const f32x2 av = __builtin_elementwise_abs(v), d = av * 0.2316418882f + 1.0f;
    f32x2 t; t.x = __builtin_amdgcn_rcpf(d.x); t.y = __builtin_amdgcn_rcpf(d.y);
    f32x2 q = t * 0.5307027145f + (-0.7265760135f); q = q * t + 0.7107068705f; q = q * t + (-0.142248368f); q = q * t + 0.127414796f; q = q * t;
    const f32x2 s = (v * v) * (-0.72134752044f);
    f32x2 e; e.x = __builtin_amdgcn_exp2f(s.x); e.y = __builtin_amdgcn_exp2f(s.y);
    const f32x2 m = v * (q * e), r = v - m;
    f32x2 o; o.x = v.x < 0.f ? m.x : r.x; o.y = v.y < 0.f ? m.y : r.y; return o;
}

struct ConvPipe { P0Row a[2], b[2]; f32x4 gs[4]; };
__device__ __forceinline__ void conv_init(Frame& F, ConvPipe& C) {
#pragma unroll
    for (int i = 0; i < 4; ++i) C.gs[i] = *(const GAS f32x4*)(F.in[I_LN2] + 4 * (F.lane + 64 * i)) * 256.0f;
}
__device__ __forceinline__ void conv_issue(Frame& F, ConvPipe& C, int s) {
    const int gw = F.vcu * NWAVES + F.wave, NGW = F.G * NWAVES;
#pragma unroll
    for (int r = 0; r < 2; ++r) { const size_t m = (size_t)(gw + (2 * s + r) * NGW); p0_fp8_load(C.a[r], F.in[I_PU] + m * D, F.lane); p0_fp8_load(C.b[r], F.in[I_PV] + m * D, F.lane); }
}
__device__ __forceinline__ void conv_store_row(const P0Row& R, unsigned char* dst, int e, int lane, const f32x4 (&sc)[4], bool scaled) {
#pragma unroll
    for (int i = 0; i < 4; ++i) { const f32x4 sv = scaled ? sc[i] : (f32x4){256.0f, 256.0f, 256.0f, 256.0f};
        int w = 0; w = __builtin_amdgcn_cvt_pk_fp8_f32(R.v[i][0] * sv[0], R.v[i][1] * sv[1], w, false); w = __builtin_amdgcn_cvt_pk_fp8_f32(R.v[i][2] * sv[2], R.v[i][3] * sv[3], w, true);
        __builtin_nontemporal_store(w, (GAS int*)(dst + ((size_t)(2 * i + (lane >> 5)) * NEXP + e) * 128 + 4 * (lane & 31))); }
}
__device__ __forceinline__ void conv_retire(Frame& F, const ConvPipe& C, int s) {
    const int gw = F.vcu * NWAVES + F.wave, NGW = F.G * NWAVES;
#pragma unroll
    for (int r = 0; r < 2; ++r) { const int m = gw + (2 * s + r) * NGW; conv_store_row(C.a[r], F.ws + 18 * MiB, m, F.lane, C.gs, true); conv_store_row(C.b[r], F.ws + 34 * MiB, m, F.lane, C.gs, false); }
}
constexpr int S5_KT = 0, S5_U = 32768, S5_SX = 98304, S5_H0 = 115200;
template <int VAR> __device__ __forceinline__ void s5_unit(Frame& F, int b, int g, ConvPipe& C) {
    LAS unsigned char* L = F.lds; int tid = F.tid, lane = F.lane; asm volatile("" : "+v"(tid), "+v"(lane));
    const int w = F.wave; int r32 = lane & 31, hi = lane >> 5;
    const bf16* U5 = (const bf16*)(F.ws + WS_U5); bf16* YS5 = (bf16*)(F.ws + WS_YS5);
    const bf16* KTg = (const bf16*)(F.ws + WS_KT) + (size_t)g * 64 * 256;
    const bf16* Eg = (const bf16*)(F.ws + WS_E) + (size_t)g * 128 * 1024;
    const bf16* Fg = (const bf16*)(F.ws + WS_F) + (size_t)g * 1024 * 128;
#pragma unroll
    for (int k = 0; k < 4; ++k) { const int q = tid + 512 * k, lag = q >> 5, c = (q >> 1) & 15, h2 = q & 1;
        *(LAS v4u*)(L + S5_KT + (h2 * 1024 + lag * 16 + c) * 16) = *(const GAS v4u*)(KTg + (size_t)q * 8); }
#pragma unroll
    for (int k = 0; k < 8; ++k) { const int q = tid + 512 * k, l = q >> 1, h2 = q & 1, n = l >> 6, i = l & 63;
        *(LAS v4u*)(L + S5_U + (h2 * 2048 + i * 32 + n) * 16) = *(const GAS v4u*)(U5 + ((size_t)(b * 32 + g) * SEQ + l) * 16 + 8 * h2); }
    LDS_WAIT(); __syncthreads();
    if (VAR == 3) return;
    {
        const int rtE = w & 3, kh = w >> 2; f32x16 acc = {};
        const bf16* erow = Eg + ((size_t)rtE * 64 * 64 + lane) * 8;
#pragma unroll 8
        for (int ii = 0; ii < 32; ++ii) { const int i = 32 * kh + ii;
            const bf16x8 a = *(const GAS bf16x8*)(erow + (size_t)i * 512); const bf16x8 bb = lds_ld8(L, S5_U + (hi * 2048 + i * 32 + r32) * 16);
            acc = MFMA32(a, bb, acc); }
        f32x2 a64v = {0.f, 0.f}; if (tid < 64) a64v = *(const GAS f32x2*)((const float*)(F.ws + WS_A64) + (g * 64 + tid) * 2);
        conv_retire(F, C, 0); conv_issue(F, C, 1);
        LAS float* SX = (LAS float*)(L + S5_SX);
        if (kh == 1) {
#pragma unroll
            for (int r = 0; r < 16; ++r) SX[(32 * rtE + crow(r, hi)) * 33 + r32] = acc[r];
        }
        LDS_WAIT(); __syncthreads();
        if (kh == 0) {
#pragma unroll
            for (int r = 0; r < 16; ++r) SX[(32 * rtE + crow(r, hi)) * 33 + r32] += acc[r];
        }
        LDS_WAIT(); __syncthreads();
        if (tid < 64) {
            const int p = tid; const float ar = a64v[0], ai = a64v[1];
            float hr = 0.f, hm = 0.f;
            const int offr = ((((p >> 4) * 2) + ((p >> 3) & 1)) * 32) * 16 + (p & 7) * 2, offi = (((((64 + p) >> 4) * 2) + ((p >> 3) & 1)) * 32) * 16 + (p & 7) * 2;
            for (int n = 0; n < 32; ++n) {
                *(LAS unsigned short*)(L + S5_H0 + offr + n * 16) = (unsigned short)f2bf(hr);
                *(LAS unsigned short*)(L + S5_H0 + offi + n * 16) = (unsigned short)f2bf(hm);
                const float sr = SX[p * 33 + n], si = SX[(64 + p) * 33 + n];
                const float nr = ar * hr - ai * hm + sr, ni = ar * hm + ai * hr + si; hr = nr; hm = ni;
            }
        }
        LDS_WAIT(); __syncthreads();
    }
    if (VAR == 1) return;
    const f32x4 dsk = *(const GAS f32x4*)(F.in[I_S5D] + g * 16 + 4 * hi), dsk8 = *(const GAS f32x4*)(F.in[I_S5D] + g * 16 + 8 + 4 * hi);
#pragma unroll 1
    for (int q = 0; q < 4; ++q) {
        const int rt = (q == 0) ? w : (q == 1) ? 15 - w : (q == 2) ? 16 + w : 31 - w;
        { int lo_ = lane; asm volatile("" : "+v"(lo_)); r32 = lo_ & 31; hi = lo_ >> 5; }
        const int jl = r32 >> 4, c = r32 & 15;
        f32x16 acc = {};
        const int abase = S5_KT + (hi * 1024 + (2 * rt + jl) * 16 + c) * 16, bbase = S5_U + (hi * 2048 + r32) * 16;
        bf16x8 ff[8];
        { const bf16* frow_ = Fg + ((size_t)rt * 8 * 64 + lane) * 8;
#pragma unroll
          for (int ks = 0; ks < 8; ++ks) ff[ks] = *(const GAS bf16x8*)(frow_ + ks * 512); }
        if (q < 3) { conv_retire(F, C, q + 1); if (q < 2) conv_issue(F, C, q + 2); }
        { bf16x8 an = lds_ld8(L, abase), bn = lds_ld8(L, bbase);
#pragma unroll 4
          for (int i = 0; i <= 2 * rt; ++i) { const bf16x8 a = an, bb = bn; const int i1 = (i < 2 * rt) ? i + 1 : i; an = lds_ld8(L, abase - i1 * 256); bn = lds_ld8(L, bbase + i1 * 512); acc = MFMA32(a, bb, acc); } }
        { const int i = 2 * rt + 1; bf16x8 a = lds_ld8(L, S5_KT + (hi * 1024 + c) * 16); if (jl == 0) a = (bf16x8){0, 0, 0, 0, 0, 0, 0, 0};
          const bf16x8 bb = lds_ld8(L, bbase + i * 512); acc = MFMA32(a, bb, acc); }
#pragma unroll
        for (int ks = 0; ks < 8; ++ks) { const bf16x8 bb = lds_ld8(L, S5_H0 + ((ks * 2 + hi) * 32 + r32) * 16); acc = MFMA32(ff[ks], bb, acc); }
        if (VAR == 2) { asm volatile("" :: "v"(acc[0]), "v"(acc[5]), "v"(acc[10]), "v"(acc[15])); continue; }
#pragma unroll
        for (int gq = 0; gq < 4; ++gq) {
            const int jl2 = gq >> 1, i = 2 * rt + jl2;
            const v2u uu = *(LAS const v2u*)(L + S5_U + ((gq & 1) * 2048 + i * 32 + r32) * 16 + 8 * hi);
            const f32x4 dd = (gq & 1) ? dsk8 : dsk;
            const f32x2 y01 = gelu_pk((f32x2){acc[4 * gq + 0] + dd[0] * blo(uu.x), acc[4 * gq + 1] + dd[1] * bhi(uu.x)});
            const f32x2 y23 = gelu_pk((f32x2){acc[4 * gq + 2] + dd[2] * blo(uu.y), acc[4 * gq + 3] + dd[3] * bhi(uu.y)});
            v2u o; o.x = pk2(y01.x, y01.y); o.y = pk2(y23.x, y23.y);
            *(GAS v2u*)(YS5 + ((size_t)b * SEQ + 64 * r32 + i) * 512 + g * 16 + 8 * (gq & 1) + 4 * hi) = o;
        }
    }
    LDS_WAIT(); __syncthreads();
}

constexpr int AT_K = 0, AT_V = 32768, AT_B = 66048, AT_VSTR = 520;
constexpr float LOG2E = 1.4426950408889634f;
__device__ __forceinline__ int t5_bucket_d(int dist) { if (dist < 16) return dist; const int v = 16 + (int)(logf((float)dist / 16.0f) / logf(8.0f) * 16.0f); return v < 31 ? v : 31; }
constexpr int AT_BUF_BYTES = 69632;
static_assert(AT_B + 4 * 224 * 4 <= AT_BUF_BYTES && 2 * AT_BUF_BYTES + 2048 <= LDSCTL_OFF, "attention LDS map");
struct AttnKV { v4u kr[4], vr[4]; };
__device__ __forceinline__ void attn_load(Frame& F, AttnKV& R, int b, int kvh, int n) {
    const bf16* Kb = (const bf16*)(F.ws + WS_K); const bf16* Vb = (const bf16*)(F.ws + WS_V);
    int tid_o = F.tid; asm volatile("" : "+v"(tid_o));
#pragma unroll
    for (int k = 0; k < 4; ++k) { const int q = tid_o + 512 * k, key = q >> 3, ch = q & 7, kpos = 128 * (n - 1) + key;
        R.kr[k] = (v4u){0u, 0u, 0u, 0u}; R.vr[k] = (v4u){0u, 0u, 0u, 0u};
        if (kpos >= 0) { R.kr[k] = *(const GAS v4u*)(Kb + ((size_t)b * SEQ + kpos) * 256 + kvh * 64 + 8 * ch); R.vr[k] = *(const GAS v4u*)(Vb + ((size_t)b * SEQ + kpos) * 256 + kvh * 64 + 8 * ch); } }
}
__device__ __forceinline__ void attn_stage(Frame& F, const AttnKV& R, LAS unsigned char* L, int kvh) {
    int tid = F.tid; asm volatile("" : "+v"(tid));
#pragma unroll
    for (int k = 0; k < 4; ++k) {
        const int q = tid + 512 * k, key = q >> 3, ch = q & 7;
        const v4u kr = R.kr[k], vr = R.vr[k];
        float kf[8] = {blo(kr.x), bhi(kr.x), blo(kr.y), bhi(kr.y), blo(kr.z), bhi(kr.z), blo(kr.w), bhi(kr.w)};
        float ss = 0.f;
#pragma unroll
        for (int j = 0; j < 8; ++j) ss += kf[j] * kf[j];
        ss += __shfl_xor(ss, 1); ss += __shfl_xor(ss, 2); ss += __shfl_xor(ss, 4);
        const float rk = rsqrtf(ss * (1.0f / 64.0f) + RMS_EPS);
        const f32x4 g0 = *(const GAS f32x4*)(F.in[I_GK] + 8 * ch) * *(const GAS f32x4*)(F.in[I_GQ] + 8 * ch), g1 = *(const GAS f32x4*)(F.in[I_GK] + 8 * ch + 4) * *(const GAS f32x4*)(F.in[I_GQ] + 8 * ch + 4);
        v4u o; o.x = pk2(kf[0] * rk * g0[0], kf[1] * rk * g0[1]); o.y = pk2(kf[2] * rk * g0[2], kf[3] * rk * g0[3]);
        o.z = pk2(kf[4] * rk * g1[0], kf[5] * rk * g1[1]); o.w = pk2(kf[6] * rk * g1[2], kf[7] * rk * g1[3]);
        *(LAS v4u*)(L + AT_K + key * 128 + ((ch ^ (key & 7)) * 16)) = o;
        LAS unsigned short* vt = (LAS unsigned short*)(L + AT_V + (8 * ch) * AT_VSTR + key * 2);
        vt[0 * (AT_VSTR / 2)] = (unsigned short)(vr.x & 0xffffu); vt[1 * (AT_VSTR / 2)] = (unsigned short)(vr.x >> 16);
        vt[2 * (AT_VSTR / 2)] = (unsigned short)(vr.y & 0xffffu); vt[3 * (AT_VSTR / 2)] = (unsigned short)(vr.y >> 16);
        vt[4 * (AT_VSTR / 2)] = (unsigned short)(vr.z & 0xffffu); vt[5 * (AT_VSTR / 2)] = (unsigned short)(vr.z >> 16);
        vt[6 * (AT_VSTR / 2)] = (unsigned short)(vr.w & 0xffffu); vt[7 * (AT_VSTR / 2)] = (unsigned short)(vr.w >> 16);
    }
    { const int g = tid >> 7, dist = tid & 127; ((LAS float*)(L + AT_B))[g * 224 + 159 - dist] = F.in[I_BIAS][t5_bucket_d(dist) * 16 + 4 * kvh + g] * LOG2E; }
}
template <int VAR> __device__ __forceinline__ void attn_compute(Frame& F, LAS unsigned char* L, int b, int kvh, int n) {
    int lane = F.lane; asm volatile("" : "+v"(lane));
    const int w = F.wave, r32 = lane & 31, hi = lane >> 5;
    const bf16* Qb = (const bf16*)(F.ws + WS_Q); bf16* ATT = (bf16*)(F.ws + WS_R1);
    const int g = w >> 1, half = w & 1, h = 4 * kvh + g;
    const float sinkl = F.in[I_SINK][h] * LOG2E;
    const LAS float* BLg = (const LAS float*)(L + AT_B) + g * 224;
#pragma unroll 1
    for (int a2 = 0; a2 < 2; ++a2) {
        const int a = 2 * half + a2;
        int r32o = r32, hio = hi; asm volatile("" : "+v"(r32o), "+v"(hio));
        const size_t trow = (size_t)b * SEQ + 128 * n + 32 * a + r32o;
        bf16x8 qb[4];
        {
            v4u qr[4]; float ss = 0.f;
#pragma unroll
            for (int ks = 0; ks < 4; ++ks) { qr[ks] = *(const GAS v4u*)(Qb + trow * 1024 + h * 64 + 16 * ks + 8 * hio);
                const float f0 = blo(qr[ks].x), f1 = bhi(qr[ks].x), f2 = blo(qr[ks].y), f3 = bhi(qr[ks].y), f4 = blo(qr[ks].z), f5 = bhi(qr[ks].z), f6 = blo(qr[ks].w), f7 = bhi(qr[ks].w);
                ss += (f0 * f0 + f1 * f1) + (f2 * f2 + f3 * f3) + (f4 * f4 + f5 * f5) + (f6 * f6 + f7 * f7); }
            ss += __shfl_xor(ss, 32);
            const float rq = rsqrtf(ss * (1.0f / 64.0f) + RMS_EPS) * (0.125f * LOG2E);
#pragma unroll
            for (int ks = 0; ks < 4; ++ks) {
                v4u o; o.x = pk2(blo(qr[ks].x) * rq, bhi(qr[ks].x) * rq); o.y = pk2(blo(qr[ks].y) * rq, bhi(qr[ks].y) * rq);
                o.z = pk2(blo(qr[ks].z) * rq, bhi(qr[ks].z) * rq); o.w = pk2(blo(qr[ks].w) * rq, bhi(qr[ks].w) * rq);
                qb[ks] = __builtin_bit_cast(bf16x8, o); }
        }
        f32x16 p[5]; float m = -1e30f;
        int r32v = r32o - 4 * hio; asm volatile("" : "+v"(r32v));
        const LAS float* BLl = BLg + (31 - r32v);
#pragma unroll
        for (int kt = 0; kt < 5; ++kt) {
            f32x16 ci;
            const int key = 32 * (a + kt) + r32o;
            bf16x8 kfr[4];
#pragma unroll
            for (int ks = 0; ks < 4; ++ks) kfr[ks] = lds_ld8(L, AT_K + key * 128 + (((2 * ks + hio) ^ (key & 7)) * 16));
            const bool tile_ok = (n > 0) || (a + kt >= 4);
#pragma unroll
            for (int r = 0; r < 16; ++r) { const int cc = (r & 3) + 8 * (r >> 2);
                const float bv = BLl[32 * kt + cc];
                ci[r] = (kt == 0) ? ((cc > r32v) ? bv : -1e30f) : (kt == 4) ? ((cc <= r32v) ? bv : -1e30f) : bv; }
            if (!tile_ok) {
#pragma unroll
                for (int r = 0; r < 16; ++r) ci[r] = -1e30f;
            }
#pragma unroll
            for (int ks = 0; ks < 4; ++ks) ci = MFMA32(kfr[ks], qb[ks], ci);
            p[kt] = ci;
#pragma unroll
            for (int r = 0; r < 16; ++r) m = fmaxf(m, ci[r]);
        }
        if (VAR == 1) { asm volatile("" :: "v"(p[0][0]), "v"(p[1][3]), "v"(p[2][7]), "v"(p[3][11]), "v"(p[4][15]), "v"(m)); continue; }
        m = fmaxf(m, __shfl_xor(m, 32)); m = fmaxf(m, sinkl);
        float l = 0.f;
#pragma unroll
        for (int kt = 0; kt < 5; ++kt)
#pragma unroll
            for (int r = 0; r < 16; ++r) { const float e = __builtin_amdgcn_exp2f(p[kt][r] - m); p[kt][r] = e; l += e; }
        l += __shfl_xor(l, 32); l += __builtin_amdgcn_exp2f(sinkl - m);
        const float inv = 1.0f / l;
        f32x16 o[2]; o[0] = (f32x16){}; o[1] = (f32x16){};
#pragma unroll
        for (int kt = 0; kt < 5; ++kt)
#pragma unroll
            for (int s2 = 0; s2 < 2; ++s2) {
                v4u pw; pw.x = pk2(p[kt][8 * s2 + 0] * inv, p[kt][8 * s2 + 1] * inv); pw.y = pk2(p[kt][8 * s2 + 2] * inv, p[kt][8 * s2 + 3] * inv);
                pw.z = pk2(p[kt][8 * s2 + 4] * inv, p[kt][8 * s2 + 5] * inv); pw.w = pk2(p[kt][8 * s2 + 6] * inv, p[kt][8 * s2 + 7] * inv);
                const bf16x8 pa = __builtin_bit_cast(bf16x8, pw);
                const int base = 32 * (a + kt) + 16 * s2;
                v4u vv[2];
#pragma unroll
                for (int dt = 0; dt < 2; ++dt) { const int voff = AT_V + (32 * dt + r32o) * AT_VSTR + (base + 4 * hio) * 2;
                    const v2u lo = *(LAS const v2u*)(L + voff), h2 = *(LAS const v2u*)(L + voff + 16);
                    vv[dt] = (v4u){lo.x, lo.y, h2.x, h2.y}; }
#pragma unroll
                for (int dt = 0; dt < 2; ++dt) o[dt] = MFMA32(pa, __builtin_bit_cast(bf16x8, vv[dt]), o[dt]);
            }
        if (VAR == 2) { asm volatile("" :: "v"(o[0][0]), "v"(o[0][9]), "v"(o[1][5]), "v"(o[1][15])); continue; }
        bf16* orow = ATT + ((size_t)b * SEQ + 128 * n + 32 * a) * 1024 + h * 64 + r32o;
#pragma unroll
        for (int dt = 0; dt < 2; ++dt)
#pragma unroll
            for (int r = 0; r < 16; ++r) orow[(size_t)crow(r, hio) * 1024 + 32 * dt] = (bf16)f2bf(o[dt][r]);
    }
}
constexpr int AT_DUMMY_OFF = 2 * AT_BUF_BYTES;
__device__ __forceinline__ void attn_prefetch(Frame& F, int b, int kvh, int n) {
    const bf16* Kb = (const bf16*)(F.ws + WS_K); const bf16* Vb = (const bf16*)(F.ws + WS_V);
    LAS unsigned* dst = (LAS unsigned*)(F.lds + AT_DUMMY_OFF + F.wave * 256);
    int tid_o = F.tid; asm volatile("" : "+v"(tid_o));
#pragma unroll
    for (int k = 0; k < 4; ++k) { const int q = tid_o + 512 * k, key = q >> 3, ch = q & 7; int kpos = 128 * (n - 1) + key; kpos = kpos < 0 ? 0 : kpos;
        __builtin_amdgcn_global_load_lds((const GAS unsigned*)(Kb + ((size_t)b * SEQ + kpos) * 256 + kvh * 64 + 8 * ch), dst, 4, 0, 0);
        __builtin_amdgcn_global_load_lds((const GAS unsigned*)(Vb + ((size_t)b * SEQ + kpos) * 256 + kvh * 64 + 8 * ch), dst, 4, 0, 0); }
}
__device__ __forceinline__ void mixers_phase(Frame& F, ConvPipe& C) {
    const int NU = BATCH * NKV * 16;
    { const int u0 = F.vcu, u1 = u0 + F.G;
      if (u0 < NU) attn_prefetch(F, u0 >> 6, (u0 >> 4) & 3, u0 & 15);
      if (u1 < NU) attn_prefetch(F, u1 >> 6, (u1 >> 4) & 3, u1 & 15); }
    for (int u = F.vcu; u < BATCH * S5NG; u += F.G) s5_unit<0>(F, u >> 5, u & 31, C);
#pragma unroll 1
    for (int u0 = F.vcu; u0 < NU; u0 += 2 * F.G) {
        const int u1 = u0 + F.G; const bool has1 = u1 < NU;
        AttnKV R0, R1;
        attn_load(F, R0, u0 >> 6, (u0 >> 4) & 3, u0 & 15);
        if (has1) attn_load(F, R1, u1 >> 6, (u1 >> 4) & 3, u1 & 15);
        attn_stage(F, R0, F.lds, (u0 >> 4) & 3);
        if (has1) attn_stage(F, R1, F.lds + AT_BUF_BYTES, (u1 >> 4) & 3);
        LDS_WAIT(); __syncthreads();
        attn_compute<0>(F, F.lds, u0 >> 6, (u0 >> 4) & 3, u0 & 15);
        if (has1) attn_compute<0>(F, F.lds + AT_BUF_BYTES, u1 >> 6, (u1 >> 4) & 3, u1 & 15);
        LDS_WAIT(); __syncthreads();
    }
}
__device__ __forceinline__ int f2ord(float f) { int b = __builtin_bit_cast(int, f); return b ^ ((b >> 31) & 0x7fffffff); }
__device__ __forceinline__ float ord2f(int b) { return __builtin_bit_cast(float, b ^ ((b >> 31) & 0x7fffffff)); }
#define CE_DESC(a, b) do { const int t_ = max((a), (b)); (b) = min((a), (b)); (a) = t_; } while (0)
__device__ __forceinline__ void sort16_desc(int (&v)[16]) {
#pragma unroll
    for (int k = 2; k <= 16; k <<= 1)
#pragma unroll
        for (int j = k >> 1; j > 0; j >>= 1)
#pragma unroll
            for (int i = 0; i < 16; ++i) { const int l = i ^ j; if (l > i) { if ((i & k) == 0 || k == 16) CE_DESC(v[i], v[l]); else CE_DESC(v[l], v[i]); } }
}
__device__ __forceinline__ void bitonic_merge16_desc(int (&v)[16]) {
#pragma unroll
    for (int j = 8; j > 0; j >>= 1)
#pragma unroll
        for (int i = 0; i < 16; ++i) { const int l = i ^ j; if (l > i) CE_DESC(v[i], v[l]); }
}
__device__ __forceinline__ void merge_top16(int (&A)[16], const int (&B)[16]) {
#pragma unroll
    for (int i = 0; i < 16; ++i) A[i] = max(A[i], B[15 - i]);
    bitonic_merge16_desc(A);
}
__device__ __forceinline__ void merge_partner(int (&A)[16]) {
    int B[16];
#pragma unroll
    for (int i = 0; i < 16; ++i) B[i] = __shfl_xor(A[i], 32);
    merge_top16(A, B);
}
constexpr int TK_LDS_PER_WAVE = 2048;
constexpr int TK_SK_BYTES = 32768, TK_SCR_OFF = 2 * TK_SK_BYTES;
constexpr int QPL_RS = 272, QPL_BYTES = 256 * QPL_RS, QPL_SK_OFF = QPL_BYTES, QPL_SCR_OFF = QPL_BYTES + TK_SK_BYTES;
static_assert(QPL_SCR_OFF + 8 * TK_LDS_PER_WAVE <= RING_BYTES, "top-k LDS map");
template <bool QL> __device__ __forceinline__ void topk_item(Frame& F, int tile, int h, int skoff, int scroff = TK_SCR_OFF, int qoff = 0) {
    const int lane = F.lane, r32 = lane & 31, hi = lane >> 5;
    const bf16* QP = (const bf16*)(F.ws + WS_QP);
    unsigned short* EXP = (unsigned short*)(F.ws + WS_EXP); float* GATE = (float*)(F.ws + WS_GATE);
    const int t = tile * 32 + r32;
    int L[2][16];
#pragma unroll
    for (int k = 0; k < 2; ++k) {
        bf16x8 qb[4];
#pragma unroll
        for (int ks = 0; ks < 4; ++ks) qb[ks] = QL ? lds_ld8(F.lds, qoff + (32 * (tile & 7) + r32) * QPL_RS + (k * 64 + 16 * ks + 8 * hi) * 2) : *(const GAS bf16x8*)(QP + (size_t)t * 1024 + h * 128 + k * 64 + 16 * ks + 8 * hi);
        int top[16];
#pragma unroll
        for (int rt = 0; rt < 4; ++rt) {
            f32x16 acc = {};
#pragma unroll
            for (int ks = 0; ks < 4; ++ks) { const bf16x8 a = lds_ld8(F.lds, skoff + (((k * 4 + rt) * 4 + ks) * 64 + lane) * 16); acc = MFMA32(a, qb[ks], acc); }
            int v[16];
#pragma unroll
            for (int r = 0; r < 16; ++r) v[r] = (f2ord(acc[r]) & ~127) | (127 - 32 * rt - (r & 3) - 8 * (r >> 2) - 4 * hi);
            sort16_desc(v);
            if (rt == 0) {
#pragma unroll
                for (int i = 0; i < 16; ++i) top[i] = v[i];
            } else merge_top16(top, v);
        }
        merge_partner(top);
#pragma unroll
        for (int i = 0; i < 16; ++i) L[k][i] = top[i];
    }
    LAS unsigned char* tl = F.lds + scroff + F.wave * TK_LDS_PER_WAVE + lane * 32;
#pragma unroll
    for (int k = 0; k < 2; ++k) { v4u w;
        w.x = (127 - (L[k][0] & 127)) | ((127 - (L[k][1] & 127)) << 8) | ((127 - (L[k][2] & 127)) << 16) | ((127 - (L[k][3] & 127)) << 24);
        w.y = (127 - (L[k][4] & 127)) | ((127 - (L[k][5] & 127)) << 8) | ((127 - (L[k][6] & 127)) << 16) | ((127 - (L[k][7] & 127)) << 24);
        w.z = (127 - (L[k][8] & 127)) | ((127 - (L[k][9] & 127)) << 8) | ((127 - (L[k][10] & 127)) << 16) | ((127 - (L[k][11] & 127)) << 24);
        w.w = (127 - (L[k][12] & 127)) | ((127 - (L[k][13] & 127)) << 8) | ((127 - (L[k][14] & 127)) << 16) | ((127 - (L[k][15] & 127)) << 24);
        *(LAS v4u*)(tl + 16 * k) = w; }
    float A[16], B[16];
#pragma unroll
    for (int i = 0; i < 16; ++i) { const float v1 = ord2f(L[0][i] & ~127), v2 = ord2f(L[1][i] & ~127); A[i] = hi ? v2 : v1; B[i] = hi ? v1 : v2; }
    int c0[16], c1[16];
    const int hcode = hi << 5;
#pragma unroll
    for (int j = 0; j < 16; ++j) c0[j] = (f2ord(A[0] + B[j]) & ~63) | (hcode + j);
#pragma unroll
    for (int j = 1; j < 8; ++j) c1[j - 1] = (f2ord(A[1] + B[j]) & ~63) | (hcode + 15 + j);
#pragma unroll
    for (int j = 2; j < 5; ++j) c1[5 + j] = (f2ord(A[2] + B[j]) & ~63) | (hcode + 21 + j);
    c1[10] = (f2ord(A[3] + B[3]) & ~63) | (hcode + 26);
#pragma unroll
    for (int j = 11; j < 16; ++j) c1[j] = (int)0x80000000;
    if (hi) { c0[0] = (int)0x80000000; c1[0] = (int)0x80000000; c1[7] = (int)0x80000000; c1[10] = (int)0x80000000; }
    sort16_desc(c0); sort16_desc(c1); merge_top16(c0, c1); merge_partner(c0);
    LDS_WAIT();
    float vals[16]; int eid[16];
    const LAS unsigned char* tb = F.lds + scroff + F.wave * TK_LDS_PER_WAVE + (lane & 31) * 32;
#pragma unroll
    for (int r = 0; r < 16; ++r) {
        const int key = c0[r], code = key & 63, hs = code >> 5, pid = code & 31;
        const int i = (pid >= 16) + (pid >= 23) + (pid >= 26);
        const int j = pid - (i == 0 ? 0 : i == 1 ? 16 : i == 2 ? 23 : 26) + i;
        const int i1 = hs ? j : i, i2 = hs ? i : j;
        eid[r] = (int)tb[i1] * 128 + (int)tb[16 + i2];
        vals[r] = ord2f(key & ~63);
    }
    float sum = 0.f; const float mx = vals[0];
#pragma unroll
    for (int r = 0; r < 16; ++r) { vals[r] = __expf(vals[r] - mx); sum += vals[r]; }
    const float inv = 1.0f / sum;
    int eo[8]; float go[8];
#pragma unroll
    for (int r = 0; r < 8; ++r) { eo[r] = hi ? eid[r + 8] : eid[r]; go[r] = (hi ? vals[r + 8] : vals[r]) * inv; }
    const size_t ob = (size_t)t * 128 + h * 16 + 8 * hi;
    *(GAS v4u*)(EXP + ob) = (v4u){(unsigned)eo[0] | ((unsigned)eo[1] << 16), (unsigned)eo[2] | ((unsigned)eo[3] << 16), (unsigned)eo[4] | ((unsigned)eo[5] << 16), (unsigned)eo[6] | ((unsigned)eo[7] << 16)};
    *(GAS f32x4*)(GATE + ob) = (f32x4){go[0], go[1], go[2], go[3]};
    *(GAS f32x4*)(GATE + ob + 4) = (f32x4){go[4], go[5], go[6], go[7]};
    LDS_WAIT();
}
__device__ __forceinline__ void topk_unit(Frame& F, int pm, int pn) {
    const bf16* SKb = (const bf16*)(F.ws + WS_SKB);
#pragma unroll
    for (int i = 0; i < 8; ++i) { const int q = F.tid + 512 * i, hh = q >> 11, qq = q & 2047, k = qq >> 10, n = (qq >> 3) & 127, dc = qq & 7;
        const v4u v = *(const GAS v4u*)(SKb + ((size_t)(((2 * pn + hh) * 2 + k) * 128 + n)) * 64 + 8 * dc);
        *(LAS v4u*)(F.lds + hh * TK_SK_BYTES + (((k * 4 + (n >> 5)) * 4 + (dc >> 1)) * 64 + (dc & 1) * 32 + (n & 31)) * 16) = v; }
    LDS_WAIT(); __syncthreads();
    topk_item<false>(F, pm * 8 + F.wave, 2 * pn, 0);
    topk_item<false>(F, pm * 8 + F.wave, 2 * pn + 1, TK_SK_BYTES);
    LDS_WAIT(); __syncthreads();
}

namespace pg8 {
struct EpiQpTopk {
    static constexpr bool PERM = true, AFTER_DRAIN = true;
    Frame* Fp; const PG8_LAS float* rrow;
    __device__ __forceinline__ void fused(const f32x4 (&acc)[2][2][4][2], const Unit& u, int wr, int wc, int fr, int fq, PG8_LAS unsigned char* lds, int wid, int lane) const {
        Frame& F = *Fp; const bf16* SKb = (const bf16*)(F.ws + WS_SKB);
        u32x4 pk[2][2][4];
#pragma unroll
        for (int bj = 0; bj < 2; ++bj)
#pragma unroll
            for (int ai = 0; ai < 2; ++ai)
#pragma unroll
                for (int m = 0; m < 4; ++m) { const float r = rrow[wr * 64 + fr + ai * HALF + m * 16]; pk[bj][ai][m] = pack8(acc[ai][bj][m][0] * r, acc[ai][bj][m][1] * r); }
#pragma unroll
        for (int bj = 0; bj < 2; ++bj) {
            const int h = 2 * u.pn + bj;
#pragma unroll
            for (int ai = 0; ai < 2; ++ai)
#pragma unroll
                for (int m = 0; m < 4; ++m) { const int rl = wr * 64 + fr + ai * HALF + m * 16; *(PG8_LAS u32x4*)(lds + rl * QPL_RS + (wc * 32 + 8 * fq) * 2) = pk[bj][ai][m]; }
#pragma unroll
            for (int i = 0; i < 4; ++i) { const int q = F.tid + 512 * i, k = q >> 10, n = (q >> 3) & 127, dc = q & 7;
                const v4u v = *(const GAS v4u*)(SKb + ((size_t)((h * 2 + k) * 128 + n)) * 64 + 8 * dc);
                *(LAS v4u*)(F.lds + QPL_SK_OFF + (((k * 4 + (n >> 5)) * 4 + (dc >> 1)) * 64 + (dc & 1) * 32 + (n & 31)) * 16) = v; }
            LDS_WAIT(); __syncthreads();
            topk_item<true>(F, u.pm * 8 + F.wave, h, QPL_SK_OFF, QPL_SCR_OFF, 0);
            LDS_WAIT(); __syncthreads();
        }
    }
};
}
typedef unsigned char u8;
constexpr size_t WS_U8 = 18 * MiB, WS_V8 = 34 * MiB, WS_ACT = 50 * MiB, WS_XH8 = 58 * MiB, WS_XL8 = 74 * MiB, WS_P = 147 * MiB;
static_assert(WS_P + 64 * MiB <= WS_END && WS_XL8 + 16 * MiB <= WS_R1, "ws map (PEER)");
constexpr float PEER_TAB_SCALE = 256.0f, PEER_INV_SCALE = 1.0f / 256.0f;
#define MFMA16F8(a, b, c) __builtin_amdgcn_mfma_f32_16x16x32_fp8_fp8((a), (b), (c), 0, 0, 0)
__device__ __forceinline__ long mk64(unsigned lo, unsigned hi) { return (long)(((unsigned long long)hi << 32) | lo); }

struct PeerRows { v4u r[16]; };
struct PeerVTok { v4u av[2]; v4u ev[2]; };
template <int CTRL> __device__ __forceinline__ float dpp_mov(float v) { return __builtin_bit_cast(float, __builtin_amdgcn_update_dpp(0, __builtin_bit_cast(int, v), CTRL, 0xF, 0xF, true)); }
__device__ __forceinline__ void peer_u_meta(v4u (&ev)[2], const unsigned short* EXP, int t, int g8) {
#pragma unroll
    for (int k = 0; k < 2; ++k) ev[k] = *(const GAS v4u*)(EXP + (size_t)t * 128 + 16 * g8 + 8 * k);
}
typedef __amdgpu_buffer_rsrc_t peer_rsrc_t;
__device__ __forceinline__ v4u peer_ld_row(peer_rsrc_t rs, unsigned id, unsigned c16) { return __builtin_amdgcn_raw_buffer_load_b128(rs, (id << 7) | c16, 0, 0); }
__device__ __forceinline__ unsigned peer_id(const v4u (&ev)[2], int k) { const unsigned w = ev[k >> 3][(k >> 1) & 3]; return (k & 1) ? (w >> 16) : (w & 0xffffu); }
__device__ __forceinline__ void peer_rows16(PeerRows& R, peer_rsrc_t rs, unsigned c16, const v4u (&ev)[2]) {
#pragma unroll
    for (int k = 0; k < 16; ++k) R.r[k] = peer_ld_row(rs, peer_id(ev, k), c16);
}
__device__ __forceinline__ void peer_u_token(PeerRows& R, peer_rsrc_t rs, unsigned c16, const v4u (&enext)[2], v4u x0, v4u x1, unsigned* op, bool b0, bool b1, bool b2) {
    typedef _Float16 h2_t __attribute__((ext_vector_type(2)));
    h2_t xh[8];
    xh[0] = __builtin_bit_cast(h2_t, __builtin_amdgcn_cvt_pkrtz(blo(x0.x), bhi(x0.x))); xh[1] = __builtin_bit_cast(h2_t, __builtin_amdgcn_cvt_pkrtz(blo(x0.y), bhi(x0.y)));
    xh[2] = __builtin_bit_cast(h2_t, __builtin_amdgcn_cvt_pkrtz(blo(x0.z), bhi(x0.z))); xh[3] = __builtin_bit_cast(h2_t, __builtin_amdgcn_cvt_pkrtz(blo(x0.w), bhi(x0.w)));
    xh[4] = __builtin_bit_cast(h2_t, __builtin_amdgcn_cvt_pkrtz(blo(x1.x), bhi(x1.x))); xh[5] = __builtin_bit_cast(h2_t, __builtin_amdgcn_cvt_pkrtz(blo(x1.y), bhi(x1.y)));
    xh[6] = __builtin_bit_cast(h2_t, __builtin_amdgcn_cvt_pkrtz(blo(x1.z), bhi(x1.z))); xh[7] = __builtin_bit_cast(h2_t, __builtin_amdgcn_cvt_pkrtz(blo(x1.w), bhi(x1.w)));
    float d[16];
#pragma unroll
    for (int k = 0; k < 16; ++k) { const v4u rk = R.r[k];
        R.r[k] = peer_ld_row(rs, peer_id(enext, k), c16);
        float s0 = 0.f, s1 = 0.f;
#pragma unroll
        for (int dw = 0; dw < 4; ++dw) {
            s0 = __builtin_amdgcn_fdot2(__builtin_amdgcn_cvt_scalef32_pk_f16_fp8(rk[dw], 1.0f, false), xh[2 * dw], s0, false);
            s1 = __builtin_amdgcn_fdot2(__builtin_amdgcn_cvt_scalef32_pk_f16_fp8(rk[dw], 1.0f, true), xh[2 * dw + 1], s1, false); }
        d[k] = s0 + s1; }
    float r8[8], r4[4], r2[2];
#pragma unroll
    for (int i = 0; i < 8; ++i) { const float send = b0 ? d[i] : d[i + 8], keep = b0 ? d[i + 8] : d[i]; r8[i] = keep + dpp_mov<0xB1>(send); }
#pragma unroll
    for (int i = 0; i < 4; ++i) { const float send = b1 ? r8[i] : r8[i + 4], keep = b1 ? r8[i + 4] : r8[i]; r4[i] = keep + dpp_mov<0x4E>(send); }
#pragma unroll
    for (int i = 0; i < 2; ++i) { const float send = b2 ? r4[i] : r4[i + 2], keep = b2 ? r4[i + 2] : r4[i]; r2[i] = keep + __shfl_xor(send, 4); }
    *(GAS unsigned*)op = pk2(r2[0], r2[1]);
}
__device__ __forceinline__ void peer_u_phase(Frame& F) {
    const int lane = F.lane, w = F.wave, g8 = lane >> 3, c = lane & 7;
    const int x = blockIdx.x & 7, nj = F.G >> 3, j = blockIdx.x >> 3, tpw = T / nj;
    const peer_rsrc_t Us = __builtin_amdgcn_make_buffer_rsrc((void*)(F.ws + WS_U8 + (size_t)x * NEXP * 128), (short)0, NEXP * 128, 0x00020000); const unsigned c16 = 16u * (unsigned)c;
    const bf16* XN2 = (const bf16*)(F.ws + WS_R1) + 128 * x + 16 * c;
    const unsigned short* EXP = (const unsigned short*)(F.ws + WS_EXP); unsigned* P = (unsigned*)(F.ws + WS_P) + (size_t)x * T * 64;
    const bool b0 = lane & 1, b1 = lane & 2, b2 = lane & 4;
    const int slot = 16 * g8 + 8 * (b0 ? 1 : 0) + 4 * (b1 ? 1 : 0) + 2 * (b2 ? 1 : 0);
    const int nold = (tpw * 3) / 4, STR = 4;
    const int t0 = j * tpw + ((w < 4) ? w : nold + (w - 4)), tend = j * tpw + ((w < 4) ? nold : tpw);
    if (t0 >= tend) return;
#define TCL(tt) (((tt) < tend) ? (tt) : t0)
    v4u eA[2], eB[2]; PeerRows RA, RB;
    peer_u_meta(eA, EXP, t0, g8); peer_u_meta(eB, EXP, TCL(t0 + STR), g8);
    peer_rows16(RA, Us, c16, eA); peer_rows16(RB, Us, c16, eB);
    peer_u_meta(eA, EXP, TCL(t0 + 2 * STR), g8); peer_u_meta(eB, EXP, TCL(t0 + 3 * STR), g8);
#pragma unroll 1
    for (int t = t0; t < tend; t += 2 * STR) {
        const int tb = TCL(t + STR);
        const v4u xa0 = *(const GAS v4u*)(XN2 + (size_t)t * 1024), xa1 = *(const GAS v4u*)(XN2 + (size_t)t * 1024 + 8);
        const v4u xb0 = *(const GAS v4u*)(XN2 + (size_t)tb * 1024), xb1 = *(const GAS v4u*)(XN2 + (size_t)tb * 1024 + 8);
        peer_u_token(RA, Us, c16, eA, xa0, xa1, P + ((size_t)t * 128 + slot) / 2, b0, b1, b2);
        peer_u_meta(eA, EXP, TCL(t + 4 * STR), g8);
        if (t + STR < tend) peer_u_token(RB, Us, c16, eB, xb0, xb1, P + ((size_t)tb * 128 + slot) / 2, b0, b1, b2);
        peer_u_meta(eB, EXP, TCL(t + 5 * STR), g8);
    }
#undef TCL
}
__device__ __forceinline__ void peer_combine_phase(Frame& F) {
    const v2u* P = (const v2u*)(F.ws + WS_P); const float* GATE = (const float*)(F.ws + WS_GATE); v2u* ACT = (v2u*)(F.ws + WS_ACT); const float* RR = (const float*)(F.ws + WS_RROW);
    const int gt = F.vcu * (NWAVES * 64) + F.tid, NGT = F.G * NWAVES * 64;
    for (int i = gt; i < T * 32; i += NGT) {
        f32x4 s = {0.f, 0.f, 0.f, 0.f};
#pragma unroll
        for (int x = 0; x < 8; ++x) { const v2u w = *(const GAS v2u*)(P + (size_t)x * T * 32 + i); s += (f32x4){blo(w.x), bhi(w.x), blo(w.y), bhi(w.y)}; }
        const f32x4 g = *(const GAS f32x4*)(GATE + (size_t)i * 4);
        f32x4 o;
        const float rs = RR[i >> 5] * PEER_INV_SCALE;
        { const f32x2 g01 = gelu_pk((f32x2){s[0] * rs, s[1] * rs}), g23 = gelu_pk((f32x2){s[2] * rs, s[3] * rs});
          o[0] = g[0] * g01.x * PEER_INV_SCALE; o[1] = g[1] * g01.y * PEER_INV_SCALE; o[2] = g[2] * g23.x * PEER_INV_SCALE; o[3] = g[3] * g23.y * PEER_INV_SCALE; }
        v2u ow; ow.x = pk2(o[0], o[1]); ow.y = pk2(o[2], o[3]);
        *(GAS v2u*)(ACT + i) = ow;
    }
}
__device__ __forceinline__ void peer_v_meta(PeerVTok& M, const bf16* ACT, const unsigned short* EXP, int t, int g8) {
#pragma unroll
    for (int k = 0; k < 2; ++k) { M.av[k] = *(const GAS v4u*)(ACT + (size_t)t * 128 + 16 * g8 + 8 * k); M.ev[k] = *(const GAS v4u*)(EXP + (size_t)t * 128 + 16 * g8 + 8 * k); }
}
__device__ __forceinline__ void peer_v_rows(PeerRows& R, peer_rsrc_t rs, unsigned c16, const PeerVTok& M) {
#pragma unroll
    for (int k = 0; k < 16; ++k) R.r[k] = peer_ld_row(rs, peer_id(M.ev, k), c16);
}
__device__ __forceinline__ void peer_v_token(const PeerRows& R, const PeerVTok& M, f32x2 hres, float* op, bool b5, bool b4, bool b3) {
    f32x2 o[8];
#pragma unroll
    for (int p = 0; p < 8; ++p) o[p] = (f32x2){0.f, 0.f};
#pragma unroll
    for (int k = 0; k < 16; ++k) { const unsigned aw = M.av[k >> 3][(k >> 1) & 3]; const float a = (k & 1) ? bhi(aw) : blo(aw); const f32x2 aa = {a, a};
#pragma unroll
        for (int dw = 0; dw < 4; ++dw) {
            o[2 * dw] = __builtin_elementwise_fma(__builtin_amdgcn_cvt_pk_f32_fp8((int)R.r[k][dw], false), aa, o[2 * dw]);
            o[2 * dw + 1] = __builtin_elementwise_fma(__builtin_amdgcn_cvt_pk_f32_fp8((int)R.r[k][dw], true), aa, o[2 * dw + 1]); } }
    f32x2 q4[4], q2[2], q1;
#pragma unroll
    for (int i = 0; i < 4; ++i) { const f32x2 send = b5 ? o[i] : o[i + 4], keep = b5 ? o[i + 4] : o[i];
        q4[i] = (f32x2){keep.x + __shfl_xor(send.x, 32), keep.y + __shfl_xor(send.y, 32)}; }
#pragma unroll
    for (int i = 0; i < 2; ++i) { const f32x2 send = b4 ? q4[i] : q4[i + 2], keep = b4 ? q4[i + 2] : q4[i];
        q2[i] = (f32x2){keep.x + __shfl_xor(send.x, 16), keep.y + __shfl_xor(send.y, 16)}; }
    { const f32x2 send = b3 ? q2[0] : q2[1], keep = b3 ? q2[1] : q2[0]; q1 = (f32x2){keep.x + __shfl_xor(send.x, 8), keep.y + __shfl_xor(send.y, 8)}; }
    __builtin_nontemporal_store(hres + q1, (GAS f32x2*)op);
}
__device__ __forceinline__ void peer_v_phase(Frame& F, float* outp) {
    const int lane = F.lane, w = F.wave, g8 = lane >> 3, c = lane & 7;
    const int x = blockIdx.x & 7, nj = F.G >> 3, j = blockIdx.x >> 3, tpw = T / nj;
    const peer_rsrc_t Vs = __builtin_amdgcn_make_buffer_rsrc((void*)(F.ws + WS_V8 + (size_t)x * NEXP * 128), (short)0, NEXP * 128, 0x00020000); const unsigned c16 = 16u * (unsigned)c;
    const unsigned short* EXP = (const unsigned short*)(F.ws + WS_EXP); const bf16* ACT = (const bf16*)(F.ws + WS_ACT); const bf16* H1B = (const bf16*)(F.ws + WS_R1);
    const bool b5 = lane & 32, b4 = lane & 16, b3 = lane & 8;
    const int col = 128 * x + 16 * c + 8 * (b5 ? 1 : 0) + 4 * (b4 ? 1 : 0) + 2 * (b3 ? 1 : 0);
    const int nold = (tpw * 5) / 8, STR = 4;
    const int t0 = j * tpw + ((w < 4) ? w : nold + (w - 4)), tend = j * tpw + ((w < 4) ? nold : tpw);
    if (t0 >= tend) return;
    PeerVTok MA, MB; PeerRows RA, RB;
    peer_v_meta(MA, ACT, EXP, t0, g8); peer_v_rows(RA, Vs, c16, MA);
    { const int t1 = (t0 + STR < tend) ? t0 + STR : t0; peer_v_meta(MB, ACT, EXP, t1, g8); }
#pragma unroll 1
    for (int t = t0; t < tend; t += 2 * STR) {
        const int tb = (t + STR < tend) ? t + STR : t, tc = (t + 2 * STR < tend) ? t + 2 * STR : t, td = (t + 3 * STR < tend) ? t + 3 * STR : t;
        const unsigned hwa = __builtin_nontemporal_load((const GAS unsigned*)(H1B + (size_t)t * 1024 + col)), hwb = __builtin_nontemporal_load((const GAS unsigned*)(H1B + (size_t)tb * 1024 + col));
        const f32x2 ha = {blo(hwa), bhi(hwa)}, hb2 = {blo(hwb), bhi(hwb)};
        peer_v_rows(RB, Vs, c16, MB);
        peer_v_token(RA, MA, ha, outp + (size_t)t * 1024 + col, b5, b4, b3);
        peer_v_meta(MA, ACT, EXP, tc, g8); peer_v_rows(RA, Vs, c16, MA);
        if (t + STR < tend) peer_v_token(RB, MB, hb2, outp + (size_t)tb * 1024 + col, b5, b4, b3);
        peer_v_meta(MB, ACT, EXP, td, g8);
    }
}
struct Args { const float* in[25]; float* out; unsigned char* ws; int ph_lo, ph_hi, li, pad; };
enum { PH_P0 = 0, PH_GEMM1, PH_S5, PH_GLU, PH_BR1, PH_BR2, PH_OUT, PH_QP, PH_PEER_U, PH_PEER_C, PH_PEER_V, PH_COUNT };

__global__ void __launch_bounds__(NWAVES * 64, 2) mega_fwd(Args args) {
    extern __shared__ __attribute__((aligned(16))) unsigned char lds[];
    Frame F;
    F.lds = (LAS unsigned char*)lds;
    F.MISC = (volatile LAS unsigned*)(F.lds + MISC_OFF);
    F.tid = threadIdx.x; F.lane = F.tid & 63; F.wave = __builtin_amdgcn_readfirstlane(F.tid >> 6);
    F.G = gridDim.x; { const int bx = blockIdx.x; F.vcu = (F.G % 8 == 0) ? (bx % 8) * (F.G / 8) + bx / 8 : bx; }
    F.ws = args.ws; F.out = args.out; F.ctl = (gu32*)(args.ws + WS_CTL);
#pragma unroll
    for (int i = 0; i < 25; ++i) F.in[i] = args.in[i];
    for (int u = F.tid; u < (LDS_BYTES - LDSCTL_OFF) / 4; u += NWAVES * 64) ((LAS unsigned*)(F.lds + LDSCTL_OFF))[u] = 0u;
    __syncthreads();
    XcdBarrier bar = xcd_barrier_post((unsigned*)(F.ctl + CW_BAR) + args.li * XCD_BAR_WORDS, F.MISC + 8);
    const int lo = args.ph_lo, hi = args.ph_hi;
#ifndef PROBE_P0MASK
#define PROBE_P0MASK 15
#endif
#ifndef PROBE_S5VAR
#define PROBE_S5VAR 0
#endif
#ifndef PROBE_ATVAR
#define PROBE_ATVAR 0
#endif
#ifndef PROBE_REP
#define PROBE_REP -1
#endif
#define IN(k) (lo <= (k) && (k) < hi)
#define REPS(k) for (int rep_ = 0; rep_ < ((PROBE_REP == (k)) ? 2 : 1); ++rep_, (void)((PROBE_REP == (k) && rep_ == 1) ? (xcd_barrier(bar), 0) : 0))
#define SEAM(k) do { if (IN(k) && IN((k) + 1)) xcd_barrier(bar); } while (0)
    unsigned char* ws = F.ws;
    bf16* XB = (bf16*)(ws + WS_R1); bf16* ATT = XB; bf16* XN2 = XB;
    bf16* U5 = (bf16*)(ws + WS_U5); bf16* Qb = (bf16*)(ws + WS_Q); bf16* Kb = (bf16*)(ws + WS_K); bf16* Vb = (bf16*)(ws + WS_V);
    bf16* Gt = (bf16*)F.out;
    bf16* YS5 = (bf16*)(ws + WS_YS5); bf16* S5Gb = (bf16*)(ws + WS_S5G); bf16* MIX = (bf16*)(ws + WS_MIX); bf16* QP = (bf16*)(ws + WS_QP);

    if (IN(PH_P0)) REPS(PH_P0) { p0_prologue(F, rep_ ? PROBE_P0MASK : 15); VM_WAIT(); __syncthreads(); } SEAM(PH_P0);

    if (IN(PH_GEMM1)) REPS(PH_GEMM1) {
        pg8::Gemm g{XB, (const bf16*)(ws + WS_W1T), T, INW, D}; pg8::StaticOrder S; S.init(T, INW, F.G, (int)blockIdx.x);
        pg8::EpiProj E{U5, Qb, Kb, Vb, Gt, F.in[I_BGATE]};
        pg8::gemm_phase<pg8::EpiProj, pg8::StaticOrder, true, true>(F.lds, g, S, E);
    }
    ConvPipe CP;
    if (IN(PH_S5)) { conv_init(F, CP); conv_issue(F, CP, 0); }
    SEAM(PH_GEMM1);

    if (IN(PH_S5)) REPS(PH_S5) { mixers_phase(F, CP); }

    if (IN(PH_GLU)) REPS(PH_GLU) {
        pg8::Gemm g{YS5, (const bf16*)(ws + WS_WGLUT), T, 1024, 512}; pg8::StaticOrder S; S.init(T, 1024, F.G, (int)blockIdx.x);
        pg8::EpiGlu E{S5Gb};
        pg8::gemm_phase<pg8::EpiGlu, pg8::StaticOrder, true, true>(F.lds, g, S, E);
    } SEAM(PH_GLU);

    if (IN(PH_BR2)) REPS(PH_BR2) {
        pg8::Gemm g{S5Gb, (const bf16*)(ws + WS_WS5T), T, 1024, 1536, ATT, 512}; pg8::StaticOrder S; S.init(T, 1024, F.G, (int)blockIdx.x);
        pg8::EpiGateDual E{MIX, 1024, Gt};
        pg8::gemm_phase<pg8::EpiGateDual, pg8::StaticOrder, true, true, true>(F.lds, g, S, E);
    } SEAM(PH_BR2);

    if (IN(PH_OUT)) REPS(PH_OUT) {
        pg8::Gemm g{MIX, (const bf16*)(ws + WS_WOUT), T, 1024, 1024}; pg8::StaticOrder S; S.init(T, 1024, F.G, (int)blockIdx.x);
        pg8::EpiRes E{F.in[I_X], F.out, XN2, (float*)(ws + WS_SSQ)};
        pg8::gemm_phase<pg8::EpiRes, pg8::StaticOrder, true, true>(F.lds, g, S, E);
    } SEAM(PH_OUT);

    if (IN(PH_QP)) REPS(PH_QP) {
        pg8::Gemm g{XN2, (const bf16*)(ws + WS_WQT), T, 1024, 1024}; pg8::StaticOrder S; S.init(T, 1024, F.G, (int)blockIdx.x);
        LAS float* rrow = (LAS float*)(F.lds + RROW_OFF);
        { pg8::Unit u0; if (S.next(0, u0) && F.tid < 256) { const int row = u0.pm * 256 + F.tid; const float* sp = (const float*)(ws + WS_SSQ) + (size_t)row * 16;
            const f32x4 a0 = *(const GAS f32x4*)sp, a1 = *(const GAS f32x4*)(sp + 4), a2 = *(const GAS f32x4*)(sp + 8), a3 = *(const GAS f32x4*)(sp + 12);
            const float ssum = ((a0[0] + a0[1]) + (a0[2] + a0[3])) + ((a1[0] + a1[1]) + (a1[2] + a1[3])) + ((a2[0] + a2[1]) + (a2[2] + a2[3])) + ((a3[0] + a3[1]) + (a3[2] + a3[3]));
            const float r = rsqrtf(ssum * (1.0f / D) + RMS_EPS); rrow[F.tid] = r; if (u0.pn == 0) ((float*)(ws + WS_RROW))[row] = r; } }
        LDS_WAIT(); __syncthreads();
        pg8::EpiQpTopk E{&F, rrow};
        pg8::gemm_phase<pg8::EpiQpTopk, pg8::StaticOrder, true, true>(F.lds, g, S, E);
    } SEAM(PH_QP);

    #ifndef PROBE_UVAR
#define PROBE_UVAR 0
#endif
    if (IN(PH_PEER_U)) REPS(PH_PEER_U) { peer_u_phase(F); } SEAM(PH_PEER_U);
    if (IN(PH_PEER_C)) REPS(PH_PEER_C) { peer_combine_phase(F); } SEAM(PH_PEER_C);
    if (IN(PH_PEER_V)) REPS(PH_PEER_V) { peer_v_phase(F, rep_ ? (float*)(ws + WS_P) : F.out); }
#undef IN
#undef SEAM
}
static void launch_mega(Args a, int lo, int hi, int li, int grid, hipStream_t stream) {
    a.ph_lo = lo; a.ph_hi = hi; a.li = li; a.pad = 0;
    hipLaunchKernelGGL(mega_fwd, dim3(grid), dim3(NWAVES * 64), LDS_BYTES, stream, a);
}
extern "C" void kernel_launch(void* const* d_in, const int* in_sizes, int n_in, void* d_out, int out_size, void* d_ws, size_t ws_size, hipStream_t stream) {
    static int grid = 0;
    if (grid == 0) {
        if (n_in != 25 || out_size != T * D || ws_size < WS_END) { fprintf(stderr, "kernel_launch: unexpected shapes n_in %d out %d ws %zu\n", n_in, out_size, ws_size); grid = -1; return; }
        int dev = 0, cus = 0, per_cu = 0;
        if (hipGetDevice(&dev) != hipSuccess || hipDeviceGetAttribute(&cus, hipDeviceAttributeMultiprocessorCount, dev) != hipSuccess) { grid = -1; return; }
        if (hipFuncSetAttribute((const void*)mega_fwd, hipFuncAttributeMaxDynamicSharedMemorySize, LDS_BYTES) != hipSuccess) { fprintf(stderr, "kernel_launch: hipFuncSetAttribute failed\n"); grid = -1; return; }
        if (hipOccupancyMaxActiveBlocksPerMultiprocessor(&per_cu, (const void*)mega_fwd, NWAVES * 64, LDS_BYTES) != hipSuccess || per_cu < 1) { fprintf(stderr, "kernel_launch: occupancy query says %d\n", per_cu); grid = -1; (void)hipGetLastError(); return; }
        if (cus != 256) { fprintf(stderr, "kernel_launch: built for a 256-CU device (one 256x256 GEMM unit per workgroup in the N = 1024 phases), found %d CUs\n", cus); grid = -1; return; }
        grid = cus;
    }
    if (grid < 0) return;
    if (hipMemsetAsync((char*)d_ws + WS_CTL, 0, CTL_ZERO_BYTES, stream) != hipSuccess) { fprintf(stderr, "kernel_launch: memset failed\n"); return; }
    Args a{};
    for (int i = 0; i < 25; ++i) a.in[i] = (const float*)d_in[i];
    a.out = (float*)d_out; a.ws = (unsigned char*)d_ws;
    launch_mega(a, PH_P0, PH_COUNT, 0, grid, stream);
}
```

```cpp
#include <hip/hip_runtime.h>
#include <cstdio>
#include <cstdint>
#include <cmath>

typedef unsigned short bf16;
constexpr int D = 1024, BATCH = 8, SEQ = 2048, T = BATCH * SEQ;
constexpr int S5W = 512, S5C = 16, S5NG = 32, S5P = 64;
constexpr int NQH = 16, NKV = 4, HD = 64, WIN = 128, NBUCK = 32;
constexpr int QW = 1024, KVW = 256, GATEW = 2048, INW = 4096;
constexpr int PH = 8, NSUB = 128, NEXP = 16384, TOPK = 16;
constexpr float RMS_EPS = 1e-6f;

__device__ __forceinline__ unsigned f2bf(float f) { unsigned u = __builtin_bit_cast(unsigned, f); return (u + 0x7fffu + ((u >> 16) & 1u)) >> 16; }
__device__ __forceinline__ float bf2f(unsigned h) { return __builtin_bit_cast(float, h << 16); }
__device__ __forceinline__ float wave_sum(float v) {
#pragma unroll
    for (int o = 1; o < 64; o <<= 1) v += __shfl_xor(v, o);
    return v;
}
__device__ __forceinline__ float wave_max(float v) {
#pragma unroll
    for (int o = 1; o < 64; o <<= 1) v = fmaxf(v, __shfl_xor(v, o));
    return v;
}
__device__ __forceinline__ float gelu_erf(float x) { return 0.5f * x * (1.0f + erff(x * 0.70710678118654752f)); }
__device__ __forceinline__ float sigmoidf_(float x) { return 1.0f / (1.0f + __expf(-x)); }

constexpr size_t MiB = 1u << 20;
constexpr size_t WS_R1 = 99 * MiB;
constexpr size_t WS_U5 = 131 * MiB;
constexpr size_t WS_Q = 147 * MiB;
constexpr size_t WS_K = 179 * MiB;
constexpr size_t WS_V = 187 * MiB;
constexpr size_t WS_S5G = 131 * MiB;
constexpr size_t WS_MIX = 147 * MiB;
constexpr size_t WS_QP = 147 * MiB;
constexpr size_t WS_EXP = 131 * MiB;
constexpr size_t WS_GATE = 139 * MiB;
constexpr size_t WS_YS5 = 195 * MiB;
constexpr size_t WS_END = 211 * MiB;

namespace pg8 {
#define PG8_LAS __attribute__((address_space(3)))
typedef unsigned short bf16_t;
typedef short bf16x8 __attribute__((ext_vector_type(8)));
typedef float f32x4 __attribute__((ext_vector_type(4)));
typedef unsigned u32x4 __attribute__((ext_vector_type(4)));
constexpr int BM = 256, BK = 64, HALF = 128, HTB = HALF * BK * 2  , STAGE_BYTES = 8 * HTB, NXCD = 8, WGM = 8;

__host__ __device__ __forceinline__ int lds_byte(int r, int c) { const int st = (r >> 4) * 2 + (c >> 5), rr = r & 15, cc = c & 31, ob = rr * 64 + cc * 2; return st * 1024 + (ob ^ (((ob >> 9) & 1) << 5)); }
__host__ __device__ __forceinline__ void stage_rc(int b, int& R, int& C) { const int st = b / 1024, sb = b % 1024, swz = sb ^ (((sb >> 9) & 1) << 5); R = (st >> 1) * 16 + swz / 64; C = (st & 1) * 32 + (swz % 64) / 2; }
__host__ __device__ __forceinline__ int perm32(int rho) { const int n = rho >> 4, i = rho & 15; return 8 * (i >> 2) + 4 * n + (i & 3); }

struct Unit { int pm, pn; };
struct Gemm { const bf16_t* A; const bf16_t* Bt; int M, N, K; const bf16_t* A2 = nullptr; int K1 = 0; };

struct StaticOrder {
    int nM, nN, nwg, G, c;
    __host__ __device__ void init(int M, int N, int G_, int c_) { nM = M / BM; nN = N / BM; nwg = nM * nN; G = G_; c = c_; }
    __host__ __device__ bool next(int i, Unit& u) const {
        const long L = (long)i * G + c; if (L >= nwg) return false;
        int wgid = (int)L; { const int q = nwg / NXCD, r = nwg % NXCD, xcd = wgid % NXCD, off = wgid / NXCD; wgid = (xcd < r ? xcd * (q + 1) : r * (q + 1) + (xcd - r) * q) + off; }
        const int nig = WGM * nN, gid = wgid / nig, fm = gid * WGM, gsz = (nM - fm) < WGM ? (nM - fm) : WGM;
        u.pm = fm + ((wgid % nig) % gsz); u.pn = (wgid % nig) / gsz; return true;
    }
    __device__ __forceinline__ void a_ready(const Unit&) const {}
    __device__ __forceinline__ void done(const Unit&) const {}
};

__device__ __forceinline__ unsigned cvt_pk_bf16(float lo, float hi) { unsigned r; asm volatile("v_cvt_pk_bf16_f32 %0, %1, %2" : "=v"(r) : "v"(lo), "v"(hi)); return r; }
__device__ __forceinline__ float bflo(unsigned w) { return __builtin_bit_cast(float, w << 16); }
__device__ __forceinline__ float bfhi(unsigned w) { return __builtin_bit_cast(float, w & 0xffff0000u); }
__device__ __forceinline__ float sigm(float x) { return __builtin_amdgcn_rcpf(1.0f + __expf(-x)); }
__device__ __forceinline__ f32x4 sigm4(f32x4 v) { return (f32x4){sigm(v[0]), sigm(v[1]), sigm(v[2]), sigm(v[3])}; }
__device__ __forceinline__ u32x4 pack8(f32x4 v0, f32x4 v1) { u32x4 w; w.x = cvt_pk_bf16(v0[0], v0[1]); w.y = cvt_pk_bf16(v0[2], v0[3]); w.z = cvt_pk_bf16(v1[0], v1[1]); w.w = cvt_pk_bf16(v1[2], v1[3]); return w; }
__device__ __forceinline__ void unpack8(u32x4 w, f32x4& v0, f32x4& v1) { v0 = (f32x4){bflo(w.x), bfhi(w.x), bflo(w.y), bfhi(w.y)}; v1 = (f32x4){bflo(w.z), bfhi(w.z), bflo(w.w), bfhi(w.w)}; }

struct EpiProj {
    static constexpr bool PERM = true, AFTER_DRAIN = false;
    bf16_t *U5, *Q, *K, *V, *G; const float* bgate;
    __device__ __forceinline__ void operator()(const f32x4 (&acc)[2][2][4][2], const Unit& u, int wr, int wc, int fr, int fq) const {
        const int pn = u.pn; bf16_t* base; int ldc, colt; const bool gate = pn >= 8;
        if (pn < 2) { base = U5; ldc = 512; colt = pn * 256; }
        else if (pn < 6) { base = Q; ldc = 1024; colt = (pn - 2) * 256; }
        else if (pn == 6) { base = K; ldc = 256; colt = 0; }
        else if (pn == 7) { base = V; ldc = 256; colt = 0; }
        else { base = G; ldc = 2048; colt = (pn - 8) * 256; }
        const int row0 = u.pm * BM + wr * 64 + fr, col0 = colt + wc * 32 + 8 * fq;
        f32x4 bv[2][2];
#pragma unroll
        for (int bj = 0; bj < 2; ++bj)
#pragma unroll
            for (int n = 0; n < 2; ++n) bv[bj][n] = gate ? *(const f32x4*)(bgate + col0 + bj * HALF + 4 * n) : (f32x4){0.f, 0.f, 0.f, 0.f};
#pragma unroll
        for (int ai = 0; ai < 2; ++ai)
#pragma unroll
            for (int m = 0; m < 4; ++m) { bf16_t* rowp = base + (size_t)(row0 + ai * HALF + m * 16) * ldc + col0;
#pragma unroll
                for (int bj = 0; bj < 2; ++bj) { f32x4 v0 = acc[ai][bj][m][0] + bv[bj][0], v1 = acc[ai][bj][m][1] + bv[bj][1];
                    if (gate) { v0 = sigm4(v0); v1 = sigm4(v1); }
                    if (pn < 2) {
                        const int r = row0 + ai * HALF + m * 16, cc = col0 + bj * HALF;
                        *(u32x4*)(U5 + ((size_t)((r >> 11) * 32 + (cc >> 4)) * 2048 + (r & 2047)) * 16 + (cc & 15)) = pack8(v0, v1);
                    } else *(u32x4*)(rowp + bj * HALF) = pack8(v0, v1); } }
    }
};
struct EpiGlu {
    static constexpr bool PERM = true, AFTER_DRAIN = false;
    bf16_t* O;
    __device__ __forceinline__ void operator()(const f32x4 (&acc)[2][2][4][2], const Unit& u, int wr, int wc, int fr, int fq) const {
        const int row0 = u.pm * BM + wr * 64 + fr, col0 = u.pn * 128 + wc * 32 + 8 * fq;
#pragma unroll
        for (int ai = 0; ai < 2; ++ai)
#pragma unroll
            for (int m = 0; m < 4; ++m) { bf16_t* rowp = O + (size_t)(row0 + ai * HALF + m * 16) * 512 + col0;
                const f32x4 v0 = acc[ai][0][m][0] * sigm4(acc[ai][1][m][0]), v1 = acc[ai][0][m][1] * sigm4(acc[ai][1][m][1]);
                *(u32x4*)rowp = pack8(v0, v1); }
    }
};
template <int MODE> struct EpiGate {
    static constexpr bool PERM = true, AFTER_DRAIN = false;
    bf16_t* O; int ldc; const bf16_t* G; int goff;
    __device__ __forceinline__ void operator()(const f32x4 (&acc)[2][2][4][2], const Unit& u, int wr, int wc, int fr, int fq) const {
        const int row0 = u.pm * BM + wr * 64 + fr, col0 = u.pn * BM + wc * 32 + 8 * fq;
#pragma unroll
        for (int ai = 0; ai < 2; ++ai)
#pragma unroll
            for (int m = 0; m < 4; ++m) { const size_t row = (size_t)(row0 + ai * HALF + m * 16); bf16_t* rowp = O + row * ldc + col0;
#pragma unroll
                for (int bj = 0; bj < 2; ++bj) { f32x4 v0 = acc[ai][bj][m][0], v1 = acc[ai][bj][m][1];
                    if (MODE >= 1) { f32x4 g0, g1; unpack8(*(const u32x4*)(G + row * 2048 + goff + col0 + bj * HALF), g0, g1); v0 = v0 * g0; v1 = v1 * g1; }
                    if (MODE == 2) { f32x4 t0, t1; unpack8(*(const u32x4*)(rowp + bj * HALF), t0, t1); v0 = v0 + t0; v1 = v1 + t1; }
                    *(u32x4*)(rowp + bj * HALF) = pack8(v0, v1); } }
    }
};
struct EpiGateDual {
    static constexpr bool PERM = true, AFTER_DRAIN = false;
    bf16_t* O; int ldc; const bf16_t* G;
    static __device__ __forceinline__ f32x4 lowc(f32x4 g) { return (f32x4){fmaxf(g[0], 0x1p-60f), fmaxf(g[1], 0x1p-60f), fmaxf(g[2], 0x1p-60f), fmaxf(g[3], 0x1p-60f)}; }
    static __device__ __forceinline__ f32x4 rcp4(f32x4 g) { return (f32x4){__builtin_amdgcn_rcpf(g[0]), __builtin_amdgcn_rcpf(g[1]), __builtin_amdgcn_rcpf(g[2]), __builtin_amdgcn_rcpf(g[3])}; }
    __device__ __forceinline__ void mid(f32x4 (&acc)[2][2][4][2], const Unit& u, int wr, int wc, int fr, int fq) const {
        asm volatile("" : "+v"(fr), "+v"(fq));
        const int row0 = u.pm * BM + wr * 64 + fr, col0 = u.pn * BM + wc * 32 + 8 * fq;
#pragma unroll
        for (int ai = 0; ai < 2; ++ai)
#pragma unroll
            for (int m = 0; m < 4; ++m) { const size_t row = (size_t)(row0 + ai * HALF + m * 16);
#pragma unroll
                for (int bj = 0; bj < 2; ++bj) { f32x4 a0, a1, b0, b1;
                    unpack8(*(const u32x4*)(G + row * 2048 + col0 + bj * HALF), a0, a1); unpack8(*(const u32x4*)(G + row * 2048 + 1024 + col0 + bj * HALF), b0, b1);
                    acc[ai][bj][m][0] = acc[ai][bj][m][0] * (a0 * rcp4(lowc(b0))); acc[ai][bj][m][1] = acc[ai][bj][m][1] * (a1 * rcp4(lowc(b1))); } }
    }
    __device__ __forceinline__ void operator()(const f32x4 (&acc)[2][2][4][2], const Unit& u, int wr, int wc, int fr, int fq) const {
        asm volatile("" : "+v"(fr), "+v"(fq));
        const int row0 = u.pm * BM + wr * 64 + fr, col0 = u.pn * BM + wc * 32 + 8 * fq;
#pragma unroll
        for (int ai = 0; ai < 2; ++ai)
#pragma unroll
            for (int m = 0; m < 4; ++m) { const size_t row = (size_t)(row0 + ai * HALF + m * 16); bf16_t* rowp = O + row * ldc + col0;
#pragma unroll
                for (int bj = 0; bj < 2; ++bj) { f32x4 b0, b1; unpack8(*(const u32x4*)(G + row * 2048 + 1024 + col0 + bj * HALF), b0, b1);
                    *(u32x4*)(rowp + bj * HALF) = pack8(acc[ai][bj][m][0] * lowc(b0), acc[ai][bj][m][1] * lowc(b1)); } }
    }
};
struct EpiRes {
    static constexpr bool PERM = true, AFTER_DRAIN = false;
    const float* base; float* out; bf16_t* hb; float* ssq;
    __device__ __forceinline__ void operator()(const f32x4 (&acc)[2][2][4][2], const Unit& u, int wr, int wc, int fr, int fq) const {
        const int row0 = u.pm * BM + wr * 64 + fr, col0 = u.pn * BM + wc * 32 + 8 * fq;
#pragma unroll
        for (int ai = 0; ai < 2; ++ai)
#pragma unroll
            for (int m = 0; m < 4; ++m) { const size_t row = (size_t)(row0 + ai * HALF + m * 16), off = row * 1024 + col0; float ss = 0.f;
#pragma unroll
                for (int bj = 0; bj < 2; ++bj) {
                    const f32x4 b0 = __builtin_nontemporal_load((const f32x4*)(base + off + bj * HALF)), b1 = __builtin_nontemporal_load((const f32x4*)(base + off + bj * HALF + 4));
                    const f32x4 h0 = b0 + acc[ai][bj][m][0], h1 = b1 + acc[ai][bj][m][1];
                    *(u32x4*)(hb + off + bj * HALF) = pack8(h0, h1);
                    ss += (h0[0] * h0[0] + h0[1] * h0[1]) + (h0[2] * h0[2] + h0[3] * h0[3]) + (h1[0] * h1[0] + h1[1] * h1[1]) + (h1[2] * h1[2] + h1[3] * h1[3]); }
                ss += __shfl_xor(ss, 16); ss += __shfl_xor(ss, 32);
                if (fq == 0) ssq[row * 16 + u.pn * 4 + wc] = ss; }
    }
};
struct EpiRowScale {
    static constexpr bool PERM = true, AFTER_DRAIN = false;
    bf16_t* O; int ldc; const PG8_LAS float* rrow;
    __device__ __forceinline__ void operator()(const f32x4 (&acc)[2][2][4][2], const Unit& u, int wr, int wc, int fr, int fq) const {
        const int row0 = u.pm * BM + wr * 64 + fr, col0 = u.pn * BM + wc * 32 + 8 * fq;
#pragma unroll
        for (int ai = 0; ai < 2; ++ai)
#pragma unroll
            for (int m = 0; m < 4; ++m) { const int rl = wr * 64 + fr + ai * HALF + m * 16; const float r = rrow[rl]; bf16_t* rowp = O + (size_t)(u.pm * BM + rl) * ldc + col0;
#pragma unroll
                for (int bj = 0; bj < 2; ++bj) *(u32x4*)(rowp + bj * HALF) = pack8(acc[ai][bj][m][0] * r, acc[ai][bj][m][1] * r); }
    }
};
template <class Epi, class Sched, bool ALIGN_EPI = false, bool SP2 = false, bool DUAL = false>
__device__ __forceinline__ void gemm_phase(PG8_LAS unsigned char* lds, const Gemm g, const Sched& S, const Epi& E) {
    const int tid = threadIdx.x, wid = __builtin_amdgcn_readfirstlane(tid >> 6), lane = tid & 63, wr = wid >> 2, wc = wid & 3, fr = lane & 15, fq = lane >> 4;
    static_assert(!DUAL || SP2, "DUAL is written for the SP2 loop");
    const int K = g.K, nt = K / BK, KA = DUAL ? g.K1 : K, KA2 = K - KA, nt1 = KA / BK;
    unsigned voffA[2], voffB[2], voffA2[2];
#pragma unroll
    for (int i = 0; i < 2; ++i) { int R, C; stage_rc(tid * 16 + i * 8192, R, C); const int Rb = Epi::PERM ? ((R & ~31) + perm32(R & 31)) : R;
        voffA[i] = (unsigned)(R * KA + C) * 2u; voffB[i] = (unsigned)(Rb * K + C) * 2u; voffA2[i] = (unsigned)(R * KA2 + C) * 2u; }
    const size_t kstep = (size_t)(BK * 2);
    const size_t hstep = (size_t)HALF * K * 2;
    const size_t tstep = 2 * hstep;
    const size_t hstepA = (size_t)HALF * KA * 2, hstepA2 = (size_t)HALF * KA2 * 2;
    const unsigned ldsw = (unsigned)wid * 1024u;
    const int aoff = lds_byte(wr * 64 + fr, fq * 8), boff = lds_byte(wc * 32 + fr, fq * 8);
#define PG8_SA(b, h) (((b) * 2 + (h)) * HTB)
#define PG8_SB(b, h) ((4 + (b) * 2 + (h)) * HTB)
#define PG8_STAGE(bufoff, gbase, voff) do { _Pragma("unroll") for (int _i = 0; _i < 2; ++_i) \
        __builtin_amdgcn_global_load_lds((const unsigned*)((const char*)(gbase) + (voff)[_i]), (PG8_LAS unsigned*)(lds + (bufoff) + ldsw + _i * 8192), 16, 0, 0); } while (0)
#define PG8_STA(bufoff, optr, tt, h) do { if constexpr (DUAL) { const int _tt = (tt); const bool _s2 = _tt >= nt1; \
        const char* _p = _s2 ? cA2 + (size_t)(_tt - nt1) * kstep + (size_t)(h) * hstepA2 : cA + (size_t)_tt * kstep + (size_t)(h) * hstepA; \
        const unsigned _v[2] = {_s2 ? voffA2[0] : voffA[0], _s2 ? voffA2[1] : voffA[1]}; PG8_STAGE(bufoff, _p, _v); } else { PG8_STAGE(bufoff, optr, voffA); } } while (0)
#define PG8_LDA(dst, b, h) do { _Pragma("unroll") for (int m = 0; m < 4; ++m) _Pragma("unroll") for (int k = 0; k < 2; ++k) dst[m][k] = *(const PG8_LAS bf16x8*)(lds + PG8_SA(b, h) + aoff + m * 2048 + k * 1024); } while (0)
#define PG8_LDB(dst, b, h) do { _Pragma("unroll") for (int n = 0; n < 2; ++n) _Pragma("unroll") for (int k = 0; k < 2; ++k) dst[n][k] = *(const PG8_LAS bf16x8*)(lds + PG8_SB(b, h) + boff + n * 2048 + k * 1024); } while (0)
#define PG8_MMA(ai, bj, At, Bt) do { __builtin_amdgcn_s_setprio(1); _Pragma("unroll") for (int m = 0; m < 4; ++m) _Pragma("unroll") for (int n = 0; n < 2; ++n) _Pragma("unroll") for (int k = 0; k < 2; ++k) \
        acc[ai][bj][m][n] = __builtin_amdgcn_mfma_f32_16x16x32_bf16(Bt[n][k], At[m][k], acc[ai][bj][m][n], 0, 0, 0); __builtin_amdgcn_s_setprio(0); } while (0)
#define PG8_WAIT_V(n) asm volatile("s_waitcnt vmcnt(" #n ")" ::: "memory")
#define PG8_WAIT_L(n) asm volatile("s_waitcnt lgkmcnt(" #n ")" ::: "memory")
#define PG8_BAR __builtin_amdgcn_s_barrier()
#define PG8_SCHED __builtin_amdgcn_sched_barrier(0)
    Unit cur, nxt; int ui = 0;
    if (!S.next(0, cur)) return;
    f32x4 acc[2][2][4][2];
#pragma unroll
    for (int a = 0; a < 2; ++a)
#pragma unroll
        for (int b = 0; b < 2; ++b)
#pragma unroll
            for (int m = 0; m < 4; ++m)
#pragma unroll
                for (int n = 0; n < 2; ++n) acc[a][b][m][n] = (f32x4){0.f, 0.f, 0.f, 0.f};
    bf16x8 At[4][2], B0[2][2], B1[2][2];
    const char* cA = (const char*)g.A + (size_t)cur.pm * (DUAL ? 2 * hstepA : tstep); const char* cB = (const char*)g.Bt + (size_t)cur.pn * tstep;
    const char* cA2 = DUAL ? (const char*)g.A2 + (size_t)cur.pm * 2 * hstepA2 : cA;
    S.a_ready(cur);
    if constexpr (SP2) {
        PG8_STAGE(PG8_SB(0, 0), cB, voffB); PG8_STAGE(PG8_SB(0, 1), cB + hstep, voffB); PG8_STA(PG8_SA(0, 0), cA, 0, 0); PG8_STA(PG8_SA(0, 1), cA + hstep, 0, 1);
        if (wr == 1) PG8_BAR;
        PG8_WAIT_V(2); PG8_BAR;
        PG8_STAGE(PG8_SB(1, 0), cB + kstep, voffB); PG8_STA(PG8_SA(1, 0), cA + kstep, 1, 0); PG8_STAGE(PG8_SB(1, 1), cB + hstep + kstep, voffB);
        PG8_WAIT_V(6); PG8_BAR;
    } else {
        PG8_STAGE(PG8_SB(0, 0), cB, voffB); PG8_STAGE(PG8_SA(0, 0), cA, voffA); PG8_STAGE(PG8_SB(0, 1), cB + hstep, voffB); PG8_STAGE(PG8_SA(0, 1), cA + hstep, voffA);
        if (wr == 1) PG8_BAR;
        PG8_WAIT_V(4); PG8_BAR;
        PG8_STAGE(PG8_SB(1, 0), cB + kstep, voffB); PG8_STAGE(PG8_SA(1, 0), cA + kstep, voffA); PG8_STAGE(PG8_SB(1, 1), cB + hstep + kstep, voffB);
        PG8_WAIT_V(6); PG8_BAR;
    }
    for (;;) {
        const bool has_next = S.next(ui + 1, nxt);
        const char* nA = has_next ? (const char*)g.A + (size_t)nxt.pm * tstep : cA; const char* nB = has_next ? (const char*)g.Bt + (size_t)nxt.pn * tstep : cB;
        for (int t = 0; t < nt; t += 2) {
            const bool last = (t == nt - 2);
            const char* a1 = cA + (size_t)(t + 1) * kstep;
            const char* a2 = last ? nA : cA + (size_t)(t + 2) * kstep; const char* b2 = last ? nB : cB + (size_t)(t + 2) * kstep;
            const char* a3 = a2 + kstep; const char* b3 = b2 + kstep;
            if (last && has_next) S.a_ready(nxt);
            const int tt2 = last ? 0 : t + 2, tt3 = tt2 + 1;
            if constexpr (DUAL) { if (t == nt1) E.mid(acc, cur, wr, wc, fr, fq); }
            if constexpr (SP2) {
            PG8_LDB(B0, 0, 0); PG8_LDB(B1, 0, 1); PG8_SCHED; PG8_LDA(At, 0, 0); PG8_STA(PG8_SA(1, 1), a1 + hstep, t + 1, 1);
            PG8_WAIT_V(8); PG8_WAIT_L(0); PG8_BAR; PG8_MMA(0, 0, At, B0); PG8_MMA(0, 1, At, B1); PG8_BAR; PG8_SCHED;
            PG8_LDA(At, 0, 1); PG8_STAGE(PG8_SB(0, 0), b2, voffB); PG8_STAGE(PG8_SB(0, 1), b2 + hstep, voffB); PG8_STA(PG8_SA(0, 0), a2, tt2, 0);
            PG8_WAIT_V(8); PG8_WAIT_L(0); PG8_BAR; PG8_MMA(1, 0, At, B0); PG8_MMA(1, 1, At, B1); PG8_BAR; PG8_SCHED;
            PG8_LDB(B0, 1, 0); PG8_LDB(B1, 1, 1); PG8_SCHED; PG8_LDA(At, 1, 0); PG8_STA(PG8_SA(0, 1), a2 + hstep, tt2, 1);
            PG8_WAIT_V(8); PG8_WAIT_L(0); PG8_BAR; PG8_MMA(0, 0, At, B0); PG8_MMA(0, 1, At, B1); PG8_BAR; PG8_SCHED;
            PG8_LDA(At, 1, 1); PG8_STAGE(PG8_SB(1, 0), b3, voffB); PG8_STAGE(PG8_SB(1, 1), b3 + hstep, voffB); PG8_STA(PG8_SA(1, 0), a3, tt3, 0);
            PG8_WAIT_V(8); PG8_WAIT_L(0); PG8_BAR; PG8_MMA(1, 0, At, B0); PG8_MMA(1, 1, At, B1); PG8_BAR; PG8_SCHED;
            } else {
            PG8_LDB(B0, 0, 0); PG8_SCHED; PG8_LDA(At, 0, 0); PG8_STAGE(PG8_SA(1, 1), a1 + hstep, voffA);
            PG8_WAIT_L(8); PG8_BAR; PG8_WAIT_L(0); PG8_MMA(0, 0, At, B0); PG8_BAR; PG8_SCHED;
            PG8_LDB(B1, 0, 1); PG8_STAGE(PG8_SB(0, 0), b2, voffB);
            PG8_BAR; PG8_WAIT_L(0); PG8_MMA(0, 1, At, B1); PG8_BAR;
            PG8_LDA(At, 0, 1); PG8_STAGE(PG8_SA(0, 0), a2, voffA);
            PG8_BAR; PG8_WAIT_L(0); PG8_MMA(1, 0, At, B0); PG8_BAR; PG8_SCHED;
            PG8_STAGE(PG8_SB(0, 1), b2 + hstep, voffB);
            PG8_WAIT_V(6); PG8_BAR; PG8_MMA(1, 1, At, B1); PG8_BAR;
            PG8_LDB(B0, 1, 0); PG8_SCHED; PG8_LDA(At, 1, 0); PG8_STAGE(PG8_SA(0, 1), a2 + hstep, voffA);
            PG8_WAIT_L(8); PG8_BAR; PG8_WAIT_L(0); PG8_MMA(0, 0, At, B0); PG8_BAR; PG8_SCHED;
            PG8_LDB(B1, 1, 1); PG8_STAGE(PG8_SB(1, 0), b3, voffB);
            PG8_BAR; PG8_WAIT_L(0); PG8_MMA(0, 1, At, B1); PG8_BAR;
            PG8_LDA(At, 1, 1); PG8_STAGE(PG8_SA(1, 0), a3, voffA);
            PG8_BAR; PG8_WAIT_L(0); PG8_MMA(1, 0, At, B0); PG8_BAR; PG8_SCHED;
            PG8_STAGE(PG8_SB(1, 1), b3 + hstep, voffB);
            PG8_WAIT_V(6); PG8_BAR; PG8_MMA(1, 1, At, B1); PG8_BAR;
            }
        }
        if constexpr (ALIGN_EPI) { if (wr == 0) PG8_BAR; }
        if constexpr (!Epi::AFTER_DRAIN) { E(acc, cur, wr, wc, fr, fq); S.done(cur); }
        if (!has_next) break;
#pragma unroll
        for (int a = 0; a < 2; ++a)
#pragma unroll
            for (int b = 0; b < 2; ++b)
#pragma unroll
                for (int m = 0; m < 4; ++m)
#pragma unroll
                    for (int n = 0; n < 2; ++n) acc[a][b][m][n] = (f32x4){0.f, 0.f, 0.f, 0.f};
        cur = nxt; cA = nA; cB = nB; ++ui;
        if constexpr (ALIGN_EPI) { if (wr == 1) PG8_BAR; }
    }
    PG8_WAIT_V(0);
    if constexpr (!ALIGN_EPI) { if (wr == 0) PG8_BAR; }
    PG8_BAR;
    if constexpr (Epi::AFTER_DRAIN) { E.fused(acc, cur, wr, wc, fr, fq, lds, wid, lane); S.done(cur); }
#undef PG8_SA
#undef PG8_SB
#undef PG8_STAGE
#undef PG8_STA
#undef PG8_LDA
#undef PG8_LDB
#undef PG8_MMA
#undef PG8_WAIT_V
#undef PG8_WAIT_L
#undef PG8_BAR
#undef PG8_SCHED
}
}
constexpr int NWAVES = 8;
constexpr size_t WS_CTL = 0, CTL_ZERO_BYTES = 64 * 1024;
constexpr size_t WS_A64 = 512 * 1024;
constexpr size_t WS_W1T = 1 * MiB;
constexpr size_t WS_WGLUT = 9 * MiB;
constexpr size_t WS_WS5T = 10 * MiB;
constexpr size_t WS_WATT = 11 * MiB;
constexpr size_t WS_WOUT = 13 * MiB;
constexpr size_t WS_WQT = 15 * MiB;
constexpr size_t WS_SKB = 17 * MiB;
constexpr size_t WS_UB = 18 * MiB;
constexpr size_t WS_VB = 50 * MiB;
constexpr size_t WS_KT = 82 * MiB;
constexpr size_t WS_E = 83 * MiB;
constexpr size_t WS_F = 91 * MiB;
static_assert(WS_F + 8 * MiB <= WS_R1, "ws map");
constexpr size_t WS_RROW = 768 * 1024;
constexpr size_t WS_SSQ = 58 * MiB;
constexpr int CW_BAR = 1024;

constexpr int RING_BYTES = 131072;
constexpr int LDSCTL_OFF = 142336, MISC_OFF = LDSCTL_OFF + 320, RROW_OFF = LDSCTL_OFF + 1024;
constexpr int LDS_BYTES = 147456;
#define GAS __attribute__((address_space(1)))
#define LAS __attribute__((address_space(3)))
typedef unsigned v4u __attribute__((ext_vector_type(4)));
typedef unsigned v2u __attribute__((ext_vector_type(2)));
typedef float f32x4 __attribute__((ext_vector_type(4)));
typedef float f32x16 __attribute__((ext_vector_type(16)));
typedef short bf16x8 __attribute__((ext_vector_type(8)));
typedef GAS unsigned gu32;
#define RLX_AGENT __ATOMIC_RELAXED, __HIP_MEMORY_SCOPE_AGENT
#define LDS_WAIT() asm volatile("s_waitcnt lgkmcnt(0)" ::: "memory")
#define VM_WAIT() asm volatile("s_waitcnt vmcnt(0)" ::: "memory")
__device__ __forceinline__ unsigned pk2(float lo, float hi) { return f2bf(lo) | (f2bf(hi) << 16); }
__device__ __forceinline__ unsigned cvtpk(float lo, float hi) { unsigned r; asm volatile("v_cvt_pk_bf16_f32 %0, %1, %2" : "=v"(r) : "v"(lo), "v"(hi)); return r; }
__device__ __forceinline__ float blo(unsigned w) { return __builtin_bit_cast(float, w << 16); }
__device__ __forceinline__ float bhi(unsigned w) { return __builtin_bit_cast(float, w & 0xffff0000u); }
#define XB_TMO      128
#define XB_XCNT(j)  (256  + 64 * (j))
#define XB_XSUB(j)  (1280 + 64 * (j))
#define XB_XGEN(j)  (2304 + 64 * (j))
#define XB_TOP      3328
#define XB_TOPGEN   3392
#define XCD_BAR_WORDS 3456
#define XB_SPIN_CAP (1u << 18)

__device__ __forceinline__ unsigned xb_ld(unsigned* p)              { return __hip_atomic_load(p, __ATOMIC_RELAXED, __HIP_MEMORY_SCOPE_AGENT); }
__device__ __forceinline__ unsigned xb_add(unsigned* p, unsigned v) { return __hip_atomic_fetch_add(p, v, __ATOMIC_RELAXED, __HIP_MEMORY_SCOPE_AGENT); }
__device__ __forceinline__ unsigned xb_xcc_id() { return (unsigned)__builtin_amdgcn_s_getreg((3 << 11) | 20) & 0xFu; }
#define XB_SPIN(cond, bar) do { unsigned _sp = 0; while (cond) { __builtin_amdgcn_s_sleep(1); \
    if ((++_sp & 255u) == 0u) { if (xb_ld(&(bar)[XB_TMO])) break; if (_sp > XB_SPIN_CAP) { atomicAdd(&(bar)[XB_TMO], 1u); break; } } } } while (0)

struct XcdBarrier {
    unsigned* bar; unsigned x;
    volatile LAS unsigned* st;
};

__device__ __forceinline__ XcdBarrier xcd_barrier_post(unsigned* bar, volatile LAS unsigned* st) {
    XcdBarrier b; b.bar = bar; b.x = xb_xcc_id(); b.st = st;
    if (threadIdx.x == 0) (void)xb_add(&bar[XB_XCNT(b.x)], 1u);
    return b;
}
__device__ __forceinline__ void xcd_barrier_complete(unsigned* bar, unsigned x, unsigned& nloc, unsigned& nx) {
    const unsigned G = gridDim.x * gridDim.y * gridDim.z;
    unsigned sum, cnt, mine, sp = 0u;
    for (;;) {
        sum = 0u; cnt = 0u; mine = 0u;
#pragma unroll
        for (unsigned j = 0; j < 16; ++j) { const unsigned c = xb_ld(&bar[XB_XCNT(j)]); sum += c; cnt += (c > 0u) ? 1u : 0u; mine = (j == x) ? c : mine; }
        if (sum == G) break;
        __builtin_amdgcn_s_sleep(1);
        if ((++sp & 255u) == 0u) { if (xb_ld(&bar[XB_TMO])) break; if (sp > XB_SPIN_CAP) { atomicAdd(&bar[XB_TMO], 1u); break; } }
    }
    nloc = mine > 0u ? mine : 1u; nx = cnt > 0u ? cnt : 1u;
}

__device__ __forceinline__ void xcd_barrier(const XcdBarrier& b) {
    asm volatile("s_waitcnt vmcnt(0)" ::: "memory");
    __syncthreads();
    if (threadIdx.x == 0) {
        unsigned* bar = b.bar;
        __builtin_amdgcn_s_waitcnt(0);
        unsigned nloc = b.st[0], nx = b.st[1];
        if (nloc == 0u) { xcd_barrier_complete(bar, b.x, nloc, nx); b.st[0] = nloc; b.st[1] = nx; }
        const unsigned old = xb_add(&bar[XB_XSUB(b.x)], 1u);
        const unsigned gen = old / nloc;
        if (old + 1u == (gen + 1u) * nloc) {
            __builtin_amdgcn_fence(__ATOMIC_RELEASE, "agent");
            asm volatile("s_waitcnt vmcnt(0)" ::: "memory");
            const unsigned og = xb_add(&bar[XB_TOP], 1u);
            const unsigned tg = og / nx;
            if (og + 1u == (tg + 1u) * nx) xb_add(&bar[XB_TOPGEN], 1u);
            else XB_SPIN(xb_ld(&bar[XB_TOPGEN]) == tg, bar);
            __builtin_amdgcn_fence(__ATOMIC_ACQUIRE, "agent");
            xb_add(&bar[XB_XGEN(b.x)], 1u);
            asm volatile("s_waitcnt vmcnt(0)" ::: "memory");
        } else {
            XB_SPIN(xb_ld(&bar[XB_XGEN(b.x)]) == gen, bar);
            __builtin_amdgcn_fence(__ATOMIC_ACQUIRE, "agent");
            asm volatile("s_waitcnt vmcnt(0)" ::: "memory");
        }
    }
    __syncthreads();
}
struct Frame {
    LAS unsigned char* lds;
    volatile LAS unsigned* MISC;
    gu32* ctl;
    int tid, lane, wave, vcu, G;
    const float* in[25]; float* out; unsigned char* ws;
#ifdef STAMP_K
    unsigned long long st0, st1;
#endif
};
enum { I_X = 0, I_LN1, I_WIN, I_BGATE, I_LRE, I_LIM, I_LSTEP, I_BRE, I_BIM, I_CRE, I_CIM, I_S5D, I_WGLU, I_WS5B, I_GQ, I_GK, I_BIAS, I_SINK, I_WATT, I_WOUT, I_LN2, I_WQ, I_SK, I_PU, I_PV };

template <bool GLU>
__device__ __forceinline__ void p0_transpose_item(const float* W, int K, int N, bf16* WT, LAS float* scr, int item, int lane, const float* kscale = nullptr, int ldw = 0) {
    if (ldw == 0) ldw = K;
    const int nblk = N / 32, kb = item / nblk, nb = item % nblk, k0 = 64 * kb, n0 = 32 * nb;
#pragma unroll 8
    for (int i = 0; i < 32; ++i) { const int kk = 2 * i + (lane >> 5); const float sc_ = kscale ? kscale[k0 + kk] : 1.0f; scr[kk * 33 + (lane & 31)] = __builtin_nontemporal_load((const GAS float*)(W + (size_t)(k0 + kk) * N + n0 + (lane & 31))) * sc_; }
    LDS_WAIT(); asm volatile("" ::: "memory");
    const int c = lane & 7;
#pragma unroll
    for (int j = 0; j < 4; ++j) { const int n = (lane >> 3) + 8 * j; const LAS float* s = scr + (8 * c) * 33 + n;
        v4u o; o.x = pk2(s[0 * 33], s[1 * 33]); o.y = pk2(s[2 * 33], s[3 * 33]); o.z = pk2(s[4 * 33], s[5 * 33]); o.w = pk2(s[6 * 33], s[7 * 33]);
        const int nn = n0 + n; const int row = GLU ? (256 * ((nn & 511) >> 7) + 128 * (nn >> 9) + (nn & 127)) : nn;
        *(GAS v4u*)(WT + (size_t)row * ldw + k0 + 8 * c) = o; }
    LDS_WAIT(); asm volatile("" ::: "memory");
}
struct TrDesc { const float* W; bf16* WT; const float* kscale; int K, N, ldw, item; bool glu; };
struct TrRegs { f32x4 v[8]; };
__device__ __forceinline__ void tr_load(const TrDesc& d, TrRegs& R, int lane) {
    const int nblk = d.N / 32, kb = d.item / nblk, nb = d.item % nblk, k0 = 64 * kb, n0 = 32 * nb;
#pragma unroll
    for (int i = 0; i < 8; ++i) R.v[i] = __builtin_nontemporal_load((const GAS f32x4*)(d.W + (size_t)(k0 + 8 * i + (lane >> 3)) * d.N + n0 + 4 * (lane & 7)));
}
__device__ __forceinline__ void tr_finish(const TrDesc& d, const TrRegs& R, LAS float* scr, int lane) {
    const int nblk = d.N / 32, kb = d.item / nblk, nb = d.item % nblk, k0 = 64 * kb, n0 = 32 * nb;
#pragma unroll
    for (int i = 0; i < 8; ++i) { const int kk = 8 * i + (lane >> 3); const float sc_ = d.kscale ? d.kscale[k0 + kk] : 1.0f; LAS float* sp = scr + kk * 33 + 4 * (lane & 7);
        sp[0] = R.v[i][0] * sc_; sp[1] = R.v[i][1] * sc_; sp[2] = R.v[i][2] * sc_; sp[3] = R.v[i][3] * sc_; }
    LDS_WAIT(); asm volatile("" ::: "memory");
    const int c = lane & 7;
#pragma unroll
    for (int j = 0; j < 4; ++j) { const int n = (lane >> 3) + 8 * j; const LAS float* s = scr + (8 * c) * 33 + n;
        v4u o; o.x = pk2(s[0 * 33], s[1 * 33]); o.y = pk2(s[2 * 33], s[3 * 33]); o.z = pk2(s[4 * 33], s[5 * 33]); o.w = pk2(s[6 * 33], s[7 * 33]);
        const int nn = n0 + n; const int row = d.glu ? (256 * ((nn & 511) >> 7) + 128 * (nn >> 9) + (nn & 127)) : nn;
        *(GAS v4u*)(d.WT + (size_t)row * d.ldw + k0 + 8 * c) = o; }
    LDS_WAIT(); asm volatile("" ::: "memory");
}
__device__ __forceinline__ void p0_convert_row(const float* src, bf16* dst, int lane) {
#pragma unroll
    for (int j = 0; j < 2; ++j) { const int c = lane + 64 * j; const f32x4 a = *(const GAS f32x4*)(src + 8 * c), b = *(const GAS f32x4*)(src + 8 * c + 4);
        v4u o; o.x = pk2(a[0], a[1]); o.y = pk2(a[2], a[3]); o.z = pk2(b[0], b[1]); o.w = pk2(b[2], b[3]); *(GAS v4u*)(dst + 8 * c) = o; }
}
template <bool FP8>
__device__ __forceinline__ void rms_row_to_bf16(const float* xrow, const float* g, bf16* orow, int lane, unsigned char* oh = nullptr, unsigned char* ol = nullptr) {
    const GAS f32x4* xr = (const GAS f32x4*)xrow + lane;
    f32x4 v[4]; float s = 0.f;
#pragma unroll
    for (int j = 0; j < 4; ++j) { v[j] = xr[64 * j]; s += (v[j].x * v[j].x + v[j].y * v[j].y) + (v[j].z * v[j].z + v[j].w * v[j].w); }
    s = wave_sum(s);
    const float r = rsqrtf(s * (1.0f / D) + RMS_EPS);
    const GAS f32x4* gr = (const GAS f32x4*)g + lane;
    GAS v2u* o = (GAS v2u*)orow + lane;
#pragma unroll
    for (int j = 0; j < 4; ++j) { const f32x4 gg = gr[64 * j]; const f32x4 y = {v[j].x * r * gg.x, v[j].y * r * gg.y, v[j].z * r * gg.z, v[j].w * r * gg.w};
        v2u w; w.x = pk2(y.x, y.y); w.y = pk2(y.z, y.w); o[64 * j] = w;
        if (FP8) { int h = 0; h = __builtin_amdgcn_cvt_pk_fp8_f32(y.x, y.y, h, false); h = __builtin_amdgcn_cvt_pk_fp8_f32(y.z, y.w, h, true);
            const auto h01 = __builtin_amdgcn_cvt_pk_f32_fp8(h, false), h23 = __builtin_amdgcn_cvt_pk_f32_fp8(h, true);
            int l = 0; l = __builtin_amdgcn_cvt_pk_fp8_f32(y.x - h01[0], y.y - h01[1], l, false); l = __builtin_amdgcn_cvt_pk_fp8_f32(y.z - h23[0], y.w - h23[1], l, true);
            ((GAS int*)oh)[lane + 64 * j] = h; ((GAS int*)ol)[lane + 64 * j] = l; } }
}
template <int NR>
__device__ __forceinline__ void rms_rows_to_bf16(const float* x, size_t row_stride, const float* g, bf16* o, int lane) {
    f32x4 v[NR][4]; float s[NR];
#pragma unroll
    for (int r = 0; r < NR; ++r)
#pragma unroll
        for (int j = 0; j < 4; ++j) v[r][j] = __builtin_nontemporal_load((const GAS f32x4*)(x + r * row_stride) + lane + 64 * j);
#pragma unroll
    for (int r = 0; r < NR; ++r) { s[r] = 0.f;
#pragma unroll
        for (int j = 0; j < 4; ++j) s[r] += (v[r][j].x * v[r][j].x + v[r][j].y * v[r][j].y) + (v[r][j].z * v[r][j].z + v[r][j].w * v[r][j].w); }
#pragma unroll
    for (int of = 1; of < 64; of <<= 1)
#pragma unroll
        for (int r = 0; r < NR; ++r) s[r] += __shfl_xor(s[r], of);
    const GAS f32x4* gr = (const GAS f32x4*)g + lane;
#pragma unroll
    for (int j = 0; j < 4; ++j) { const f32x4 gg = gr[64 * j];
#pragma unroll
        for (int r = 0; r < NR; ++r) { const float rr = rsqrtf(s[r] * (1.0f / D) + RMS_EPS); v2u w;
            w.x = pk2(v[r][j].x * rr * gg.x, v[r][j].y * rr * gg.y); w.y = pk2(v[r][j].z * rr * gg.z, v[r][j].w * rr * gg.w); ((GAS v2u*)(o + r * row_stride) + lane)[64 * j] = w; } }
}
struct XPipe { f32x4 v[4][4]; };
__device__ __forceinline__ void x_issue(XPipe& X, const float* x, size_t row_stride, int lane) {
#pragma unroll
    for (int r = 0; r < 4; ++r)
#pragma unroll
        for (int j = 0; j < 4; ++j) X.v[r][j] = __builtin_nontemporal_load((const GAS f32x4*)(x + r * row_stride) + lane + 64 * j);
}
__device__ __forceinline__ void x_retire(const XPipe& X, size_t row_stride, const float* g, bf16* o, int lane) {
    float s[4];
#pragma unroll
    for (int r = 0; r < 4; ++r) { s[r] = 0.f;
#pragma unroll
        for (int j = 0; j < 4; ++j) s[r] += (X.v[r][j].x * X.v[r][j].x + X.v[r][j].y * X.v[r][j].y) + (X.v[r][j].z * X.v[r][j].z + X.v[r][j].w * X.v[r][j].w); }
#pragma unroll
    for (int of = 1; of < 64; of <<= 1)
#pragma unroll
        for (int r = 0; r < 4; ++r) s[r] += __shfl_xor(s[r], of);
    const GAS f32x4* gr = (const GAS f32x4*)g + lane;
#pragma unroll
    for (int j = 0; j < 4; ++j) { const f32x4 gg = gr[64 * j];
#pragma unroll
        for (int r = 0; r < 4; ++r) { const float rr = rsqrtf(s[r] * (1.0f / D) + RMS_EPS); v2u w;
            w.x = pk2(X.v[r][j].x * rr * gg.x, X.v[r][j].y * rr * gg.y); w.y = pk2(X.v[r][j].z * rr * gg.z, X.v[r][j].w * rr * gg.w); ((GAS v2u*)(o + r * row_stride) + lane)[64 * j] = w; } }
}
struct P0Row { f32x4 v[4]; };
__device__ __forceinline__ void p0_fp8_load(P0Row& R, const float* src, int lane) {
#pragma unroll
    for (int i = 0; i < 4; ++i) R.v[i] = __builtin_nontemporal_load((const GAS f32x4*)(src + 4 * (lane + 64 * i)));
}
__device__ __forceinline__ void p0_fp8_store(const P0Row& R, unsigned char* dst, int e, int lane, const float* cscale = nullptr) {
    const float S = 256.0f;
#pragma unroll
    for (int i = 0; i < 4; ++i) { f32x4 sv = {S, S, S, S}; if (cscale) sv = sv * *(const GAS f32x4*)(cscale + 4 * (lane + 64 * i));
        int w = 0; w = __builtin_amdgcn_cvt_pk_fp8_f32(R.v[i][0] * sv[0], R.v[i][1] * sv[1], w, false); w = __builtin_amdgcn_cvt_pk_fp8_f32(R.v[i][2] * sv[2], R.v[i][3] * sv[3], w, true);
        __builtin_nontemporal_store(w, (GAS int*)(dst + ((size_t)(2 * i + (lane >> 5)) * NEXP + e) * 128 + 4 * (lane & 31))); }
}
__device__ __forceinline__ void p0_s5_tables(Frame& F_, int item, XPipe& X, bool dox) {
    const int g = item >> 3, tb = item & 7, tid = F_.tid;
    LAS float* pwA = (LAS float*)(F_.lds);
    LAS float* pwB = pwA + 1024;
    LAS float* pwC = pwB + 1024;
    LAS float* bbL = pwC + 1024;
    LAS float* fwA = bbL + 2048;
    const float* lam_re = F_.in[I_LRE]; const float* lam_im = F_.in[I_LIM];
    const float st = expf(F_.in[I_LSTEP][g]);
    {
        const int jj = tid >> 6, p = tid & 63, j = 8 * tb + jj;
        const float lr = lam_re[g * 64 + p], li = lam_im[g * 64 + p];
        const float tA = (float)j * st, tB = (float)(j + 1) * st, tC = (float)(63 - j) * st;
        const float mA = __expf(lr * tA), mB = __expf(lr * tB), mC = __expf(lr * tC);
        pwA[tid * 2] = mA * __cosf(li * tA); pwA[tid * 2 + 1] = mA * __sinf(li * tA);
        pwB[tid * 2] = mB * __cosf(li * tB); pwB[tid * 2 + 1] = mB * __sinf(li * tB);
        pwC[tid * 2] = mC * __cosf(li * tC); pwC[tid * 2 + 1] = mC * __sinf(li * tC);
        if (tb == 0 && jj == 0) { const float t64 = 64.0f * st, m64 = expf(lr * t64); float* a64 = (float*)(F_.ws + WS_A64) + (g * 64 + p) * 2; a64[0] = m64 * cosf(li * t64); a64[1] = m64 * sinf(li * t64); }
    }
    for (int idx = tid; idx < 1024; idx += 512) {
        const int p = idx >> 4, c = idx & 15;
        const float lr = lam_re[g * 64 + p], li = lam_im[g * 64 + p];
        const float mag = expf(lr * st), are = mag * cosf(li * st), aim = mag * sinf(li * st);
        const float den = lr * lr + li * li, nr = are - 1.0f, ni = aim;
        const float cfr = (nr * lr + ni * li) / den, cfi = (ni * lr - nr * li) / den;
        const float br = F_.in[I_BRE][(g * 64 + p) * 16 + c], bi = F_.in[I_BIM][(g * 64 + p) * 16 + c];
        bbL[p * 16 + c] = cfr * br - cfi * bi; bbL[(64 + p) * 16 + c] = cfr * bi + cfi * br;
    }
    __syncthreads();
    bf16* Fg = (bf16*)(F_.ws + WS_F) + (size_t)g * 1024 * 128;
    bf16* Eg = (bf16*)(F_.ws + WS_E) + (size_t)g * 128 * 1024;
    bf16* KTg = (bf16*)(F_.ws + WS_KT) + (size_t)g * 64 * 256;
    for (int idx = tid; idx < 2048; idx += 512) {
        const int oct = idx & 15, c = (idx >> 4) & 15, jj = idx >> 8, p0 = 8 * (oct & 7); const bool isim = oct >> 3;
        const f32x4 cr0 = *(const GAS f32x4*)(F_.in[I_CRE] + (g * 16 + c) * 64 + p0), cr1 = *(const GAS f32x4*)(F_.in[I_CRE] + (g * 16 + c) * 64 + p0 + 4);
        const f32x4 ci0 = *(const GAS f32x4*)(F_.in[I_CIM] + (g * 16 + c) * 64 + p0), ci1 = *(const GAS f32x4*)(F_.in[I_CIM] + (g * 16 + c) * 64 + p0 + 4);
        float fB[8], fA[8];
#pragma unroll
        for (int e = 0; e < 8; ++e) { const float cr = e < 4 ? cr0[e & 3] : cr1[e & 3], ci = e < 4 ? ci0[e & 3] : ci1[e & 3];
            const float br_ = pwB[(jj * 64 + p0 + e) * 2], bi_ = pwB[(jj * 64 + p0 + e) * 2 + 1], ar_ = pwA[(jj * 64 + p0 + e) * 2], ai_ = pwA[(jj * 64 + p0 + e) * 2 + 1];
            fB[e] = isim ? -(cr * bi_ + ci * br_) : (cr * br_ - ci * bi_); fA[e] = isim ? -(cr * ai_ + ci * ar_) : (cr * ar_ - ci * ai_); }
        const int j_ = 8 * tb + jj;
        v4u o; o.x = pk2(fB[0], fB[1]); o.y = pk2(fB[2], fB[3]); o.z = pk2(fB[4], fB[5]); o.w = pk2(fB[6], fB[7]);
        *(GAS v4u*)(Fg + ((size_t)(((j_ >> 1) * 8 + (oct >> 1)) * 64 + (oct & 1) * 32 + (j_ & 1) * 16 + c)) * 8) = o;
        LAS float* fw = fwA + (jj * 16 + c) * 128 + 8 * oct;
        *(LAS f32x4*)fw = (f32x4){fA[0], fA[1], fA[2], fA[3]}; *(LAS f32x4*)(fw + 4) = (f32x4){fA[4], fA[5], fA[6], fA[7]};
    }
    if (dox) {
        const int gw = F_.vcu * NWAVES + F_.wave, NGW = F_.G * NWAVES; const size_t rs = (size_t)NGW * D;
        x_retire(X, rs, F_.in[I_LN1], (bf16*)(F_.ws + WS_R1) + (size_t)gw * D, F_.lane);
        x_issue(X, F_.in[I_X] + (size_t)(gw + 4 * NGW) * D, rs, F_.lane);
    }
    for (int idx = tid; idx < 2048; idx += 512) {
        const int co = idx & 1, jj = (idx >> 1) & 7, pp = idx >> 4, p = pp & 63;
        const float pr = pwC[(jj * 64 + p) * 2], pi = pwC[(jj * 64 + p) * 2 + 1];
        const f32x4 br0 = *(const LAS f32x4*)(bbL + p * 16 + 8 * co), br1 = *(const LAS f32x4*)(bbL + p * 16 + 8 * co + 4);
        const f32x4 bi0 = *(const LAS f32x4*)(bbL + (64 + p) * 16 + 8 * co), bi1 = *(const LAS f32x4*)(bbL + (64 + p) * 16 + 8 * co + 4);
        float v[8];
#pragma unroll
        for (int e = 0; e < 8; ++e) { const float br = e < 4 ? br0[e & 3] : br1[e & 3], bi = e < 4 ? bi0[e & 3] : bi1[e & 3]; v[e] = pp < 64 ? (pr * br - pi * bi) : (pr * bi + pi * br); }
        v4u o; o.x = pk2(v[0], v[1]); o.y = pk2(v[2], v[3]); o.z = pk2(v[4], v[5]); o.w = pk2(v[6], v[7]);
        *(GAS v4u*)(Eg + ((size_t)(((pp >> 5) * 64 + (8 * tb + jj)) * 64 + co * 32 + (pp & 31))) * 8) = o;
    }
    __syncthreads();
    {
        const int cq = tid & 3, c = (tid >> 2) & 15, jj = tid >> 6;
        const LAS float* fr = fwA + (jj * 16 + c) * 128; f32x4 s4 = {0.f, 0.f, 0.f, 0.f};
#pragma unroll 8
        for (int pp = 0; pp < 128; ++pp) s4 += fr[pp] * *(const LAS f32x4*)(bbL + pp * 16 + 4 * cq);
        v2u o; o.x = pk2(s4[0], s4[1]); o.y = pk2(s4[2], s4[3]);
        *(GAS v2u*)(KTg + ((8 * tb + jj) * 16 + c) * 16 + 4 * cq) = o;
    }
    __syncthreads();
}
__device__ __forceinline__ void peer_tables_to_fp8(Frame& F) {
    const int gw = F.vcu * NWAVES + F.wave, NGW = F.G * NWAVES;
    for (int m = gw; m < NEXP; m += 4 * NGW) {
        P0Row a[4], b[4];
#pragma unroll
        for (int r = 0; r < 4; ++r) { p0_fp8_load(a[r], F.in[I_PU] + (size_t)(m + r * NGW) * D, F.lane); p0_fp8_load(b[r], F.in[I_PV] + (size_t)(m + r * NGW) * D, F.lane); }
#pragma unroll
        for (int r = 0; r < 4; ++r) { p0_fp8_store(a[r], F.ws + 18 * MiB, m + r * NGW, F.lane, F.in[I_LN2]); p0_fp8_store(b[r], F.ws + 34 * MiB, m + r * NGW, F.lane); }
    }
}
__device__ __forceinline__ void p0_prologue(Frame& F, int mask = 15) {
    const int gw = F.vcu * NWAVES + F.wave, NGW = F.G * NWAVES;
    const bool dox = (mask & 4) != 0, pipe = dox && (mask & 1) && F.vcu < 256 && T == 8 * NGW; const size_t xrs = (size_t)NGW * D;
    XPipe X;
    if (pipe) x_issue(X, F.in[I_X] + (size_t)gw * D, xrs, F.lane);
    if (mask & 1) for (int it = F.vcu; it < 256; it += F.G) p0_s5_tables(F, it, X, pipe && it == F.vcu);
    if (pipe) x_retire(X, xrs, F.in[I_LN1], (bf16*)(F.ws + WS_R1) + (size_t)(gw + 4 * NGW) * D, F.lane);
    LAS float* scr = (LAS float*)(F.lds + F.wave * 16384);
    constexpr int I1 = 16 * 128, I2 = 8 * 32, I3 = 8 * 32, I4 = 16 * 32, I5 = 16 * 32, I6 = 16 * 32, NIT = I1 + I2 + I3 + I4 + I5 + I6;
    if (mask & 2) {
        auto desc = [&](int it) { TrDesc d; int r = it; d.kscale = nullptr; d.glu = false; d.item = 0; d.W = F.in[I_WIN]; d.WT = (bf16*)(F.ws + WS_W1T); d.K = 1024; d.N = 4096; d.ldw = 1024;
            if (r < I1) { d.item = r; return d; } r -= I1;
            if (r < I2) { d.W = F.in[I_WGLU]; d.WT = (bf16*)(F.ws + WS_WGLUT); d.K = 512; d.N = 1024; d.ldw = 512; d.glu = true; d.item = r; return d; } r -= I2;
            if (r < I3) { d.W = F.in[I_WS5B]; d.WT = (bf16*)(F.ws + WS_WS5T); d.K = 512; d.N = 1024; d.ldw = 1536; d.item = r; return d; } r -= I3;
            if (r < I4) { d.W = F.in[I_WATT]; d.WT = (bf16*)(F.ws + WS_WS5T) + 512; d.K = 1024; d.N = 1024; d.ldw = 1536; d.item = r; return d; } r -= I4;
            if (r < I5) { d.W = F.in[I_WOUT]; d.WT = (bf16*)(F.ws + WS_WOUT); d.K = 1024; d.N = 1024; d.ldw = 1024; d.item = r; return d; } r -= I5;
            d.W = F.in[I_WQ]; d.WT = (bf16*)(F.ws + WS_WQT); d.K = 1024; d.N = 1024; d.ldw = 1024; d.kscale = F.in[I_LN2]; d.item = r; return d; };
        int it = gw;
        if (it < NIT) { TrDesc d = desc(it); TrRegs R; tr_load(d, R, F.lane);
#pragma unroll 1
            for (;;) { const int itn = it + NGW; const bool hn = itn < NIT; TrDesc dn = d; TrRegs Rn = R;
                if (hn) { dn = desc(itn); tr_load(dn, Rn, F.lane); }
                tr_finish(d, R, scr, F.lane);
                if (!hn) break;
                it = itn; d = dn; R = Rn; } }
    }
    if (dox && !pipe) for (int m = gw; m < T; m += 4 * NGW) rms_rows_to_bf16<4>(F.in[I_X] + (size_t)m * D, (size_t)NGW * D, F.in[I_LN1], (bf16*)(F.ws + WS_R1) + (size_t)m * D, F.lane);
    for (int m = gw; m < 128; m += NGW) p0_convert_row(F.in[I_SK] + (size_t)m * D, (bf16*)(F.ws + WS_SKB) + (size_t)m * D, F.lane);
}
__device__ __forceinline__ int crow(int r, int hi) { return (r & 3) + 8 * (r >> 2) + 4 * hi; }
#define MFMA32(a, b, c) __builtin_amdgcn_mfma_f32_32x32x16_bf16((a), (b), (c), 0, 0, 0)
typedef LAS const bf16x8* lds_b8p;
__device__ __forceinline__ bf16x8 lds_ld8(LAS unsigned char* base, int off) { return *(LAS const bf16x8*)(base + off); }
__device__ __forceinline__ float gelu_f(float x) { return 0.5f * x * (1.0f + erff(x * 0.70710678118654752f)); }
typedef float f32x2 __attribute__((ext_vector_type(2)));
__device__ __forceinline__ f32x2 gelu_pk(f32x2 v) {
    const f32x2 av = __builtin_elementwise_abs(v), d = av * 0.2316418882f + 1.0f;
    f32x2 t; t.x = __builtin_amdgcn_rcpf(d.x); t.y = __builtin_amdgcn_rcpf(d.y);
    f32x2 q = t * 0.5307027145f + (-0.7265760135f); q = q * t + 0.7107068705f; q = q * t + (-0.142248368f); q = q * t + 0.127414796f; q = q * t;
    const f32x2 s = (v * v) * (-0.72134752044f);
    f32x2 e; e.x = __builtin_amdgcn_exp2f(s.x); e.y = __builtin_amdgcn_exp2f(s.y);
    const f32x2 m = v * (q * e), r = v - m;
    f32x2 o; o.x = v.x < 0.f ? m.x : r.x; o.y = v.y < 0.f ? m.y : r.y; return o;
}

struct ConvPipe { P0Row a, b; f32x4 gs[4]; };
__device__ __forceinline__ void conv_init(Frame& F, ConvPipe& C) {
#pragma unroll
    for (int i = 0; i < 4; ++i) C.gs[i] = *(const GAS f32x4*)(F.in[I_LN2] + 4 * (F.lane + 64 * i)) * 256.0f;
}
__device__ __forceinline__ void conv_issue(Frame& F, ConvPipe& C, int s) {
    const int gw = F.vcu * NWAVES + F.wave, NGW = F.G * NWAVES; const size_t m = (size_t)(gw + s * NGW);
    p0_fp8_load(C.a, F.in[I_PU] + m * D, F.lane); p0_fp8_load(C.b, F.in[I_PV] + m * D, F.lane);
}
__device__ __forceinline__ void conv_store_row(const P0Row& R, unsigned char* dst, int e, int lane, const f32x4 (&sc)[4], bool scaled) {
#pragma unroll
    for (int i = 0; i < 4; ++i) { const f32x4 sv = scaled ? sc[i] : (f32x4){256.0f, 256.0f, 256.0f, 256.0f};
        int w = 0; w = __builtin_amdgcn_cvt_pk_fp8_f32(R.v[i][0] * sv[0], R.v[i][1] * sv[1], w, false); w = __builtin_amdgcn_cvt_pk_fp8_f32(R.v[i][2] * sv[2], R.v[i][3] * sv[3], w, true);
        __builtin_nontemporal_store(w, (GAS int*)(dst + ((size_t)(2 * i + (lane >> 5)) * NEXP + e) * 128 + 4 * (lane & 31))); }
}
__device__ __forceinline__ void conv_retire(Frame& F, const ConvPipe& C, int s) {
    const int gw = F.vcu * NWAVES + F.wave, NGW = F.G * NWAVES; const int m = gw + s * NGW;
    conv_store_row(C.a, F.ws + 18 * MiB, m, F.lane, C.gs, true); conv_store_row(C.b, F.ws + 34 * MiB, m, F.lane, C.gs, false);
}
constexpr int S5_KT = 0, S5_U = 32768, S5_SX = 98304, S5_H0 = 115200;
template <int VAR> __device__ __forceinline__ void s5_unit(Frame& F, int b, int g, ConvPipe& C) {
    LAS unsigned char* L = F.lds; int tid = F.tid, lane = F.lane; asm volatile("" : "+v"(tid), "+v"(lane));
    const int w = F.wave; int r32 = lane & 31, hi = lane >> 5;
    const bf16* U5 = (const bf16*)(F.ws + WS_U5); bf16* YS5 = (bf16*)(F.ws + WS_YS5);
    const bf16* KTg = (const bf16*)(F.ws + WS_KT) + (size_t)g * 64 * 256;
    const bf16* Eg = (const bf16*)(F.ws + WS_E) + (size_t)g * 128 * 1024;
    const bf16* Fg = (const bf16*)(F.ws + WS_F) + (size_t)g * 1024 * 128;
    const int rtE = w & 3, kh = w >> 2;
    const bf16* erow = Eg + ((size_t)rtE * 64 * 64 + lane) * 8;
    bf16x8 ef[8];
#pragma unroll
    for (int ii = 0; ii < 8; ++ii) ef[ii] = *(const GAS bf16x8*)(erow + (size_t)(32 * kh + ii) * 512);
    bf16x8 ff[8];
#pragma unroll
    for (int k = 0; k < 4; ++k) { const int q = tid + 512 * k, lag = q >> 5, c = (q >> 1) & 15, h2 = q & 1;
        *(LAS v4u*)(L + S5_KT + (h2 * 1024 + lag * 16 + c) * 16) = *(const GAS v4u*)(KTg + (size_t)q * 8); }
#pragma unroll
    for (int k = 0; k < 8; ++k) { const int q = tid + 512 * k, l = q >> 1, h2 = q & 1, n = l >> 6, i = l & 63;
        *(LAS v4u*)(L + S5_U + (h2 * 2048 + i * 32 + n) * 16) = *(const GAS v4u*)(U5 + ((size_t)(b * 32 + g) * SEQ + l) * 16 + 8 * h2); }
    conv_retire(F, C, 0); conv_issue(F, C, 1);
    LDS_WAIT(); __syncthreads();
#ifdef STAMP_K
    if (STAMP_K2 == 101) F.st1 = __builtin_amdgcn_s_memrealtime();
#endif
    if (VAR == 3) return;
    {
        f32x16 acc = {};
#pragma unroll
        for (int grp = 0; grp < 4; ++grp)
#pragma unroll
            for (int ii = 0; ii < 8; ++ii) { const int i = 32 * kh + 8 * grp + ii; const bf16x8 a = ef[ii];
                if (grp < 3) ef[ii] = *(const GAS bf16x8*)(erow + (size_t)(i + 8) * 512);
                const bf16x8 bb = lds_ld8(L, S5_U + (hi * 2048 + i * 32 + r32) * 16); acc = MFMA32(a, bb, acc); }
        f32x2 a64v = {0.f, 0.f}; if (tid < 64) a64v = *(const GAS f32x2*)((const float*)(F.ws + WS_A64) + (g * 64 + tid) * 2);
        conv_retire(F, C, 1); conv_issue(F, C, 2);
        LAS float* SX = (LAS float*)(L + S5_SX);
        if (kh == 1) {
#pragma unroll
            for (int r = 0; r < 16; ++r) SX[(32 * rtE + crow(r, hi)) * 33 + r32] = acc[r];
        }
        LDS_WAIT(); __syncthreads();
        if (kh == 0) {
#pragma unroll
            for (int r = 0; r < 16; ++r) SX[(32 * rtE + crow(r, hi)) * 33 + r32] += acc[r];
        }
        LDS_WAIT(); __syncthreads();
        if (tid < 64) {
            const int p = tid; const float ar = a64v[0], ai = a64v[1];
            float hr = 0.f, hm = 0.f;
            const int offr = ((((p >> 4) * 2) + ((p >> 3) & 1)) * 32) * 16 + (p & 7) * 2, offi = (((((64 + p) >> 4) * 2) + ((p >> 3) & 1)) * 32) * 16 + (p & 7) * 2;
            for (int n = 0; n < 32; ++n) {
                *(LAS unsigned short*)(L + S5_H0 + offr + n * 16) = (unsigned short)f2bf(hr);
                *(LAS unsigned short*)(L + S5_H0 + offi + n * 16) = (unsigned short)f2bf(hm);
                const float sr = SX[p * 33 + n], si = SX[(64 + p) * 33 + n];
                const float nr = ar * hr - ai * hm + sr, ni = ar * hm + ai * hr + si; hr = nr; hm = ni;
            }
        }
        { const bf16* frow_ = Fg + ((size_t)w * 8 * 64 + lane) * 8;
#pragma unroll
          for (int ks = 0; ks < 8; ++ks) ff[ks] = *(const GAS bf16x8*)(frow_ + ks * 512); }
        conv_retire(F, C, 2); conv_issue(F, C, 3);
        LDS_WAIT(); __syncthreads();
    }
#ifdef STAMP_K
    if (STAMP_K2 == 102) F.st1 = __builtin_amdgcn_s_memrealtime();
#endif
    if (VAR == 1) return;
    const f32x4 dsk = *(const GAS f32x4*)(F.in[I_S5D] + g * 16 + 4 * hi), dsk8 = *(const GAS f32x4*)(F.in[I_S5D] + g * 16 + 8 + 4 * hi);
#pragma unroll 1
    for (int q = 0; q < 4; ++q) {
        const int rt = (q == 0) ? w : (q == 1) ? 15 - w : (q == 2) ? 16 + w : 31 - w;
        { int lo_ = lane; asm volatile("" : "+v"(lo_)); r32 = lo_ & 31; hi = lo_ >> 5; }
        const int jl = r32 >> 4, c = r32 & 15;
        f32x16 acc = {};
        const int abase = S5_KT + (hi * 1024 + (2 * rt + jl) * 16 + c) * 16, bbase = S5_U + (hi * 2048 + r32) * 16;
        { bf16x8 an = lds_ld8(L, abase), bn = lds_ld8(L, bbase);
#pragma unroll 4
          for (int i = 0; i <= 2 * rt; ++i) { const bf16x8 a = an, bb = bn; const int i1 = (i < 2 * rt) ? i + 1 : i; an = lds_ld8(L, abase - i1 * 256); bn = lds_ld8(L, bbase + i1 * 512); acc = MFMA32(a, bb, acc); } }
        { const int i = 2 * rt + 1; bf16x8 a = lds_ld8(L, S5_KT + (hi * 1024 + c) * 16); if (jl == 0) a = (bf16x8){0, 0, 0, 0, 0, 0, 0, 0};
          const bf16x8 bb = lds_ld8(L, bbase + i * 512); acc = MFMA32(a, bb, acc); }
#pragma unroll
        for (int ks = 0; ks < 8; ++ks) { const bf16x8 bb = lds_ld8(L, S5_H0 + ((ks * 2 + hi) * 32 + r32) * 16); acc = MFMA32(ff[ks], bb, acc); }
        if (q < 3) { const int rtn = (q == 0) ? 15 - w : (q == 1) ? 16 + w : 31 - w; const bf16* frow_ = Fg + ((size_t)rtn * 8 * 64 + lane) * 8;
#pragma unroll
            for (int ks = 0; ks < 8; ++ks) ff[ks] = *(const GAS bf16x8*)(frow_ + ks * 512); }
        conv_retire(F, C, q + 3); conv_issue(F, C, q + 4);
#pragma unroll
        for (int gq = 0; gq < 4; ++gq) {
            const int jl2 = gq >> 1, i = 2 * rt + jl2;
            const v2u uu = *(LAS const v2u*)(L + S5_U + ((gq & 1) * 2048 + i * 32 + r32) * 16 + 8 * hi);
            const f32x4 dd = (gq & 1) ? dsk8 : dsk;
            const f32x2 y01 = gelu_pk((f32x2){acc[4 * gq + 0] + dd[0] * blo(uu.x), acc[4 * gq + 1] + dd[1] * bhi(uu.x)});
            const f32x2 y23 = gelu_pk((f32x2){acc[4 * gq + 2] + dd[2] * blo(uu.y), acc[4 * gq + 3] + dd[3] * bhi(uu.y)});
            v2u o; o.x = pk2(y01.x, y01.y); o.y = pk2(y23.x, y23.y);
            *(GAS v2u*)(YS5 + ((size_t)b * SEQ + 64 * r32 + i) * 512 + g * 16 + 8 * (gq & 1) + 4 * hi) = o;
        }
    }
    conv_retire(F, C, 7);
    LDS_WAIT(); __syncthreads();
}

constexpr int AT_K = 0, AT_V = 32768, AT_B = 66048, AT_VSTR = 520;
constexpr float LOG2E = 1.4426950408889634f;
__device__ __forceinline__ int t5_bucket_d(int dist) { if (dist < 16) return dist; const int v = 16 + (int)(logf((float)dist / 16.0f) / logf(8.0f) * 16.0f); return v < 31 ? v : 31; }
constexpr int AT_BUF_BYTES = 69632;
static_assert(AT_B + 4 * 224 * 4 <= AT_BUF_BYTES && 2 * AT_BUF_BYTES + 2048 <= LDSCTL_OFF, "attention LDS map");
struct AttnKV { v4u kr[4], vr[4]; };
__device__ __forceinline__ void attn_load(Frame& F, AttnKV& R, int b, int kvh, int n) {
    const bf16* Kb = (const bf16*)(F.ws + WS_K); const bf16* Vb = (const bf16*)(F.ws + WS_V);
    int tid_o = F.tid; asm volatile("" : "+v"(tid_o));
#pragma unroll
    for (int k = 0; k < 4; ++k) { const int q = tid_o + 512 * k, key = q >> 3, ch = q & 7, kpos = 128 * (n - 1) + key;
        R.kr[k] = (v4u){0u, 0u, 0u, 0u}; R.vr[k] = (v4u){0u, 0u, 0u, 0u};
        if (kpos >= 0) { R.kr[k] = *(const GAS v4u*)(Kb + ((size_t)b * SEQ + kpos) * 256 + kvh * 64 + 8 * ch); R.vr[k] = *(const GAS v4u*)(Vb + ((size_t)b * SEQ + kpos) * 256 + kvh * 64 + 8 * ch); } }
}
__device__ __forceinline__ void attn_stage(Frame& F, const AttnKV& R, LAS unsigned char* L, int kvh) {
    int tid = F.tid; asm volatile("" : "+v"(tid));
#pragma unroll
    for (int k = 0; k < 4; ++k) {
        const int q = tid + 512 * k, key = q >> 3, ch = q & 7;
        const v4u kr = R.kr[k], vr = R.vr[k];
        float kf[8] = {blo(kr.x), bhi(kr.x), blo(kr.y), bhi(kr.y), blo(kr.z), bhi(kr.z), blo(kr.w), bhi(kr.w)};
        float ss = 0.f;
#pragma unroll
        for (int j = 0; j < 8; ++j) ss += kf[j] * kf[j];
        ss += __shfl_xor(ss, 1); ss += __shfl_xor(ss, 2); ss += __shfl_xor(ss, 4);
        const float rk = rsqrtf(ss * (1.0f / 64.0f) + RMS_EPS);
        const f32x4 g0 = *(const GAS f32x4*)(F.in[I_GK] + 8 * ch) * *(const GAS f32x4*)(F.in[I_GQ] + 8 * ch), g1 = *(const GAS f32x4*)(F.in[I_GK] + 8 * ch + 4) * *(const GAS f32x4*)(F.in[I_GQ] + 8 * ch + 4);
        v4u o; o.x = pk2(kf[0] * rk * g0[0], kf[1] * rk * g0[1]); o.y = pk2(kf[2] * rk * g0[2], kf[3] * rk * g0[3]);
        o.z = pk2(kf[4] * rk * g1[0], kf[5] * rk * g1[1]); o.w = pk2(kf[6] * rk * g1[2], kf[7] * rk * g1[3]);
        *(LAS v4u*)(L + AT_K + key * 128 + ((ch ^ (key & 7)) * 16)) = o;
        LAS unsigned short* vt = (LAS unsigned short*)(L + AT_V + (8 * ch) * AT_VSTR + key * 2);
        vt[0 * (AT_VSTR / 2)] = (unsigned short)(vr.x & 0xffffu); vt[1 * (AT_VSTR / 2)] = (unsigned short)(vr.x >> 16);
        vt[2 * (AT_VSTR / 2)] = (unsigned short)(vr.y & 0xffffu); vt[3 * (AT_VSTR / 2)] = (unsigned short)(vr.y >> 16);
        vt[4 * (AT_VSTR / 2)] = (unsigned short)(vr.z & 0xffffu); vt[5 * (AT_VSTR / 2)] = (unsigned short)(vr.z >> 16);
        vt[6 * (AT_VSTR / 2)] = (unsigned short)(vr.w & 0xffffu); vt[7 * (AT_VSTR / 2)] = (unsigned short)(vr.w >> 16);
    }
    { const int g = tid >> 7, dist = tid & 127; ((LAS float*)(L + AT_B))[g * 224 + 159 - dist] = F.in[I_BIAS][t5_bucket_d(dist) * 16 + 4 * kvh + g] * LOG2E; }
}
template <int VAR> __device__ __forceinline__ void attn_compute(Frame& F, LAS unsigned char* L, int b, int kvh, int n) {
    int lane = F.lane; asm volatile("" : "+v"(lane));
    const int w = F.wave, r32 = lane & 31, hi = lane >> 5;
    const bf16* Qb = (const bf16*)(F.ws + WS_Q); bf16* ATT = (bf16*)(F.ws + WS_R1);
    const int g = w >> 1, half = w & 1, h = 4 * kvh + g;
    const float sinkl = F.in[I_SINK][h] * LOG2E;
    const LAS float* BLg = (const LAS float*)(L + AT_B) + g * 224;
#pragma unroll 1
    for (int a2 = 0; a2 < 2; ++a2) {
        const int a = 2 * half + a2;
        int r32o = r32, hio = hi; asm volatile("" : "+v"(r32o), "+v"(hio));
        const size_t trow = (size_t)b * SEQ + 128 * n + 32 * a + r32o;
        bf16x8 qb[4];
        {
            v4u qr[4]; float ss = 0.f;
#pragma unroll
            for (int ks = 0; ks < 4; ++ks) { qr[ks] = *(const GAS v4u*)(Qb + trow * 1024 + h * 64 + 16 * ks + 8 * hio);
                const float f0 = blo(qr[ks].x), f1 = bhi(qr[ks].x), f2 = blo(qr[ks].y), f3 = bhi(qr[ks].y), f4 = blo(qr[ks].z), f5 = bhi(qr[ks].z), f6 = blo(qr[ks].w), f7 = bhi(qr[ks].w);
                ss += (f0 * f0 + f1 * f1) + (f2 * f2 + f3 * f3) + (f4 * f4 + f5 * f5) + (f6 * f6 + f7 * f7); }
            ss += __shfl_xor(ss, 32);
            const float rq = rsqrtf(ss * (1.0f / 64.0f) + RMS_EPS) * (0.125f * LOG2E);
#pragma unroll
            for (int ks = 0; ks < 4; ++ks) {
                v4u o; o.x = pk2(blo(qr[ks].x) * rq, bhi(qr[ks].x) * rq); o.y = pk2(blo(qr[ks].y) * rq, bhi(qr[ks].y) * rq);
                o.z = pk2(blo(qr[ks].z) * rq, bhi(qr[ks].z) * rq); o.w = pk2(blo(qr[ks].w) * rq, bhi(qr[ks].w) * rq);
                qb[ks] = __builtin_bit_cast(bf16x8, o); }
        }
        f32x16 p[5]; float m = -1e30f;
        int r32v = r32o - 4 * hio; asm volatile("" : "+v"(r32v));
        const LAS float* BLl = BLg + (31 - r32v);
#pragma unroll
        for (int kt = 0; kt < 5; ++kt) {
            f32x16 ci;
            const int key = 32 * (a + kt) + r32o;
            bf16x8 kfr[4];
#pragma unroll
            for (int ks = 0; ks < 4; ++ks) kfr[ks] = lds_ld8(L, AT_K + key * 128 + (((2 * ks + hio) ^ (key & 7)) * 16));
            const bool tile_ok = (n > 0) || (a + kt >= 4);
#pragma unroll
            for (int r = 0; r < 16; ++r) { const int cc = (r & 3) + 8 * (r >> 2);
                const float bv = BLl[32 * kt + cc];
                ci[r] = (kt == 0) ? ((cc > r32v) ? bv : -1e30f) : (kt == 4) ? ((cc <= r32v) ? bv : -1e30f) : bv; }
            if (!tile_ok) {
#pragma unroll
                for (int r = 0; r < 16; ++r) ci[r] = -1e30f;
            }
#pragma unroll
            for (int ks = 0; ks < 4; ++ks) ci = MFMA32(kfr[ks], qb[ks], ci);
            p[kt] = ci;
#pragma unroll
            for (int r = 0; r < 16; ++r) m = fmaxf(m, ci[r]);
        }
        if (VAR == 1) { asm volatile("" :: "v"(p[0][0]), "v"(p[1][3]), "v"(p[2][7]), "v"(p[3][11]), "v"(p[4][15]), "v"(m)); continue; }
        m = fmaxf(m, __shfl_xor(m, 32)); m = fmaxf(m, sinkl);
        float l = 0.f;
#pragma unroll
        for (int kt = 0; kt < 5; ++kt)
#pragma unroll
            for (int r = 0; r < 16; ++r) { const float e = __builtin_amdgcn_exp2f(p[kt][r] - m); p[kt][r] = e; l += e; }
        l += __shfl_xor(l, 32); l += __builtin_amdgcn_exp2f(sinkl - m);
        const float inv = 1.0f / l;
        f32x16 o[2]; o[0] = (f32x16){}; o[1] = (f32x16){};
#pragma unroll
        for (int kt = 0; kt < 5; ++kt)
#pragma unroll
            for (int s2 = 0; s2 < 2; ++s2) {
                v4u pw; pw.x = pk2(p[kt][8 * s2 + 0] * inv, p[kt][8 * s2 + 1] * inv); pw.y = pk2(p[kt][8 * s2 + 2] * inv, p[kt][8 * s2 + 3] * inv);
                pw.z = pk2(p[kt][8 * s2 + 4] * inv, p[kt][8 * s2 + 5] * inv); pw.w = pk2(p[kt][8 * s2 + 6] * inv, p[kt][8 * s2 + 7] * inv);
                const bf16x8 pa = __builtin_bit_cast(bf16x8, pw);
                const int base = 32 * (a + kt) + 16 * s2;
                v4u vv[2];
#pragma unroll
                for (int dt = 0; dt < 2; ++dt) { const int voff = AT_V + (32 * dt + r32o) * AT_VSTR + (base + 4 * hio) * 2;
                    const v2u lo = *(LAS const v2u*)(L + voff), h2 = *(LAS const v2u*)(L + voff + 16);
                    vv[dt] = (v4u){lo.x, lo.y, h2.x, h2.y}; }
#pragma unroll
                for (int dt = 0; dt < 2; ++dt) o[dt] = MFMA32(pa, __builtin_bit_cast(bf16x8, vv[dt]), o[dt]);
            }
        if (VAR == 2) { asm volatile("" :: "v"(o[0][0]), "v"(o[0][9]), "v"(o[1][5]), "v"(o[1][15])); continue; }
        bf16* orow = ATT + ((size_t)b * SEQ + 128 * n + 32 * a) * 1024 + h * 64 + r32o;
#pragma unroll
        for (int dt = 0; dt < 2; ++dt)
#pragma unroll
            for (int r = 0; r < 16; ++r) orow[(size_t)crow(r, hio) * 1024 + 32 * dt] = (bf16)f2bf(o[dt][r]);
    }
}
constexpr int AT_DUMMY_OFF = 2 * AT_BUF_BYTES;
__device__ __forceinline__ void attn_prefetch(Frame& F, int b, int kvh, int n) {
    const bf16* Kb = (const bf16*)(F.ws + WS_K); const bf16* Vb = (const bf16*)(F.ws + WS_V);
    LAS unsigned* dst = (LAS unsigned*)(F.lds + AT_DUMMY_OFF + F.wave * 256);
    int tid_o = F.tid; asm volatile("" : "+v"(tid_o));
#pragma unroll
    for (int k = 0; k < 4; ++k) { const int q = tid_o + 512 * k, key = q >> 3, ch = q & 7; int kpos = 128 * (n - 1) + key; kpos = kpos < 0 ? 0 : kpos;
        __builtin_amdgcn_global_load_lds((const GAS unsigned*)(Kb + ((size_t)b * SEQ + kpos) * 256 + kvh * 64 + 8 * ch), dst, 4, 0, 0);
        __builtin_amdgcn_global_load_lds((const GAS unsigned*)(Vb + ((size_t)b * SEQ + kpos) * 256 + kvh * 64 + 8 * ch), dst, 4, 0, 0); }
}
__device__ __forceinline__ void mixers_phase(Frame& F, ConvPipe& C) {
    const int NU = BATCH * NKV * 16;
    { const int u0 = F.vcu, u1 = u0 + F.G;
      if (u0 < NU) attn_prefetch(F, u0 >> 6, (u0 >> 4) & 3, u0 & 15);
      if (u1 < NU) attn_prefetch(F, u1 >> 6, (u1 >> 4) & 3, u1 & 15); }
    for (int u = F.vcu; u < BATCH * S5NG; u += F.G) s5_unit<0>(F, u >> 5, u & 31, C);
#ifdef STAMP_K
    if (STAMP_K2 == 100) F.st1 = __builtin_amdgcn_s_memrealtime();
#endif
#pragma unroll 1
    for (int u0 = F.vcu; u0 < NU; u0 += 2 * F.G) {
        const int u1 = u0 + F.G; const bool has1 = u1 < NU;
        AttnKV R0, R1;
        attn_load(F, R0, u0 >> 6, (u0 >> 4) & 3, u0 & 15);
        if (has1) attn_load(F, R1, u1 >> 6, (u1 >> 4) & 3, u1 & 15);
        attn_stage(F, R0, F.lds, (u0 >> 4) & 3);
        if (has1) attn_stage(F, R1, F.lds + AT_BUF_BYTES, (u1 >> 4) & 3);
        LDS_WAIT(); __syncthreads();
        attn_compute<0>(F, F.lds, u0 >> 6, (u0 >> 4) & 3, u0 & 15);
        if (has1) attn_compute<0>(F, F.lds + AT_BUF_BYTES, u1 >> 6, (u1 >> 4) & 3, u1 & 15);
        LDS_WAIT(); __syncthreads();
    }
}
__device__ __forceinline__ int f2ord(float f) { int b = __builtin_bit_cast(int, f); return b ^ ((b >> 31) & 0x7fffffff); }
__device__ __forceinline__ float ord2f(int b) { return __builtin_bit_cast(float, b ^ ((b >> 31) & 0x7fffffff)); }
#define CE_DESC(a, b) do { const int t_ = max((a), (b)); (b) = min((a), (b)); (a) = t_; } while (0)
__device__ __forceinline__ void sort16_desc(int (&v)[16]) {
#pragma unroll
    for (int k = 2; k <= 16; k <<= 1)
#pragma unroll
        for (int j = k >> 1; j > 0; j >>= 1)
#pragma unroll
            for (int i = 0; i < 16; ++i) { const int l = i ^ j; if (l > i) { if ((i & k) == 0 || k == 16) CE_DESC(v[i], v[l]); else CE_DESC(v[l], v[i]); } }
}
__device__ __forceinline__ void bitonic_merge16_desc(int (&v)[16]) {
#pragma unroll
    for (int j = 8; j > 0; j >>= 1)
#pragma unroll
        for (int i = 0; i < 16; ++i) { const int l = i ^ j; if (l > i) CE_DESC(v[i], v[l]); }
}
__device__ __forceinline__ void merge_top16(int (&A)[16], const int (&B)[16]) {
#pragma unroll
    for (int i = 0; i < 16; ++i) A[i] = max(A[i], B[15 - i]);
    bitonic_merge16_desc(A);
}
__device__ __forceinline__ void merge_partner(int (&A)[16]) {
    int B[16];
#pragma unroll
    for (int i = 0; i < 16; ++i) B[i] = __shfl_xor(A[i], 32);
    merge_top16(A, B);
}
constexpr int TK_LDS_PER_WAVE = 2048;
constexpr int TK_SK_BYTES = 32768, TK_SCR_OFF = 2 * TK_SK_BYTES;
constexpr int QPL_RS = 272, QPL_BYTES = 256 * QPL_RS, QPL_SK_OFF = QPL_BYTES, QPL_SCR_OFF = QPL_BYTES + TK_SK_BYTES;
static_assert(QPL_SCR_OFF + 8 * TK_LDS_PER_WAVE <= RING_BYTES, "top-k LDS map");
template <bool QL> __device__ __forceinline__ void topk_item(Frame& F, int tile, int h, int skoff, int scroff = TK_SCR_OFF, int qoff = 0) {
    const int lane = F.lane, r32 = lane & 31, hi = lane >> 5;
    const bf16* QP = (const bf16*)(F.ws + WS_QP);
    unsigned short* EXP = (unsigned short*)(F.ws + WS_EXP); float* GATE = (float*)(F.ws + WS_GATE);
    const int t = tile * 32 + r32;
    int L[2][16];
#pragma unroll
    for (int k = 0; k < 2; ++k) {
        bf16x8 qb[4];
#pragma unroll
        for (int ks = 0; ks < 4; ++ks) qb[ks] = QL ? lds_ld8(F.lds, qoff + (32 * (tile & 7) + r32) * QPL_RS + (k * 64 + 16 * ks + 8 * hi) * 2) : *(const GAS bf16x8*)(QP + (size_t)t * 1024 + h * 128 + k * 64 + 16 * ks + 8 * hi);
        int top[16];
#pragma unroll
        for (int rt = 0; rt < 4; ++rt) {
            f32x16 acc = {};
#pragma unroll
            for (int ks = 0; ks < 4; ++ks) { const bf16x8 a = lds_ld8(F.lds, skoff + (((k * 4 + rt) * 4 + ks) * 64 + lane) * 16); acc = MFMA32(a, qb[ks], acc); }
            int v[16];
#pragma unroll
            for (int r = 0; r < 16; ++r) v[r] = (f2ord(acc[r]) & ~127) | (127 - 32 * rt - (r & 3) - 8 * (r >> 2) - 4 * hi);
            sort16_desc(v);
            if (rt == 0) {
#pragma unroll
                for (int i = 0; i < 16; ++i) top[i] = v[i];
            } else merge_top16(top, v);
        }
        merge_partner(top);
#pragma unroll
        for (int i = 0; i < 16; ++i) L[k][i] = top[i];
    }
    LAS unsigned char* tl = F.lds + scroff + F.wave * TK_LDS_PER_WAVE + lane * 32;
#pragma unroll
    for (int k = 0; k < 2; ++k) { v4u w;
        w.x = (127 - (L[k][0] & 127)) | ((127 - (L[k][1] & 127)) << 8) | ((127 - (L[k][2] & 127)) << 16) | ((127 - (L[k][3] & 127)) << 24);
        w.y = (127 - (L[k][4] & 127)) | ((127 - (L[k][5] & 127)) << 8) | ((127 - (L[k][6] & 127)) << 16) | ((127 - (L[k][7] & 127)) << 24);
        w.z = (127 - (L[k][8] & 127)) | ((127 - (L[k][9] & 127)) << 8) | ((127 - (L[k][10] & 127)) << 16) | ((127 - (L[k][11] & 127)) << 24);
        w.w = (127 - (L[k][12] & 127)) | ((127 - (L[k][13] & 127)) << 8) | ((127 - (L[k][14] & 127)) << 16) | ((127 - (L[k][15] & 127)) << 24);
        *(LAS v4u*)(tl + 16 * k) = w; }
    float A[16], B[16];
#pragma unroll
    for (int i = 0; i < 16; ++i) { const float v1 = ord2f(L[0][i] & ~127), v2 = ord2f(L[1][i] & ~127); A[i] = hi ? v2 : v1; B[i] = hi ? v1 : v2; }
    int c0[16], c1[16];
    const int hcode = hi << 5;
#pragma unroll
    for (int j = 0; j < 16; ++j) c0[j] = (f2ord(A[0] + B[j]) & ~63) | (hcode + j);
#pragma unroll
    for (int j = 1; j < 8; ++j) c1[j - 1] = (f2ord(A[1] + B[j]) & ~63) | (hcode + 15 + j);
#pragma unroll
    for (int j = 2; j < 5; ++j) c1[5 + j] = (f2ord(A[2] + B[j]) & ~63) | (hcode + 21 + j);
    c1[10] = (f2ord(A[3] + B[3]) & ~63) | (hcode + 26);
#pragma unroll
    for (int j = 11; j < 16; ++j) c1[j] = (int)0x80000000;
    if (hi) { c0[0] = (int)0x80000000; c1[0] = (int)0x80000000; c1[7] = (int)0x80000000; c1[10] = (int)0x80000000; }
    sort16_desc(c0); sort16_desc(c1); merge_top16(c0, c1); merge_partner(c0);
    LDS_WAIT();
    float vals[16]; int eid[16];
    const LAS unsigned char* tb = F.lds + scroff + F.wave * TK_LDS_PER_WAVE + (lane & 31) * 32;
#pragma unroll
    for (int r = 0; r < 16; ++r) {
        const int key = c0[r], code = key & 63, hs = code >> 5, pid = code & 31;
        const int i = (pid >= 16) + (pid >= 23) + (pid >= 26);
        const int j = pid - (i == 0 ? 0 : i == 1 ? 16 : i == 2 ? 23 : 26) + i;
        const int i1 = hs ? j : i, i2 = hs ? i : j;
        eid[r] = (int)tb[i1] * 128 + (int)tb[16 + i2];
        vals[r] = ord2f(key & ~63);
    }
    float sum = 0.f; const float mx = vals[0];
#pragma unroll
    for (int r = 0; r < 16; ++r) { vals[r] = __expf(vals[r] - mx); sum += vals[r]; }
    const float inv = 1.0f / sum;
    int eo[8]; float go[8];
#pragma unroll
    for (int r = 0; r < 8; ++r) { eo[r] = hi ? eid[r + 8] : eid[r]; go[r] = (hi ? vals[r + 8] : vals[r]) * inv; }
    const size_t ob = (size_t)t * 128 + h * 16 + 8 * hi;
    *(GAS v4u*)(EXP + ob) = (v4u){(unsigned)eo[0] | ((unsigned)eo[1] << 16), (unsigned)eo[2] | ((unsigned)eo[3] << 16), (unsigned)eo[4] | ((unsigned)eo[5] << 16), (unsigned)eo[6] | ((unsigned)eo[7] << 16)};
    *(GAS f32x4*)(GATE + ob) = (f32x4){go[0], go[1], go[2], go[3]};
    *(GAS f32x4*)(GATE + ob + 4) = (f32x4){go[4], go[5], go[6], go[7]};
    LDS_WAIT();
}
__device__ __forceinline__ void topk_unit(Frame& F, int pm, int pn) {
    const bf16* SKb = (const bf16*)(F.ws + WS_SKB);
#pragma unroll
    for (int i = 0; i < 8; ++i) { const int q = F.tid + 512 * i, hh = q >> 11, qq = q & 2047, k = qq >> 10, n = (qq >> 3) & 127, dc = qq & 7;
        const v4u v = *(const GAS v4u*)(SKb + ((size_t)(((2 * pn + hh) * 2 + k) * 128 + n)) * 64 + 8 * dc);
        *(LAS v4u*)(F.lds + hh * TK_SK_BYTES + (((k * 4 + (n >> 5)) * 4 + (dc >> 1)) * 64 + (dc & 1) * 32 + (n & 31)) * 16) = v; }
    LDS_WAIT(); __syncthreads();
    topk_item<false>(F, pm * 8 + F.wave, 2 * pn, 0);
    topk_item<false>(F, pm * 8 + F.wave, 2 * pn + 1, TK_SK_BYTES);
    LDS_WAIT(); __syncthreads();
}

namespace pg8 {
struct EpiQpTopk {
    static constexpr bool PERM = true, AFTER_DRAIN = true;
    Frame* Fp; const PG8_LAS float* rrow;
    __device__ __forceinline__ void fused(const f32x4 (&acc)[2][2][4][2], const Unit& u, int wr, int wc, int fr, int fq, PG8_LAS unsigned char* lds, int wid, int lane) const {
        Frame& F = *Fp; const bf16* SKb = (const bf16*)(F.ws + WS_SKB);
        u32x4 pk[2][2][4];
#pragma unroll
        for (int bj = 0; bj < 2; ++bj)
#pragma unroll
            for (int ai = 0; ai < 2; ++ai)
#pragma unroll
                for (int m = 0; m < 4; ++m) { const float r = rrow[wr * 64 + fr + ai * HALF + m * 16]; pk[bj][ai][m] = pack8(acc[ai][bj][m][0] * r, acc[ai][bj][m][1] * r); }
#pragma unroll
        for (int bj = 0; bj < 2; ++bj) {
            const int h = 2 * u.pn + bj;
#pragma unroll
            for (int ai = 0; ai < 2; ++ai)
#pragma unroll
                for (int m = 0; m < 4; ++m) { const int rl = wr * 64 + fr + ai * HALF + m * 16; *(PG8_LAS u32x4*)(lds + rl * QPL_RS + (wc * 32 + 8 * fq) * 2) = pk[bj][ai][m]; }
#pragma unroll
            for (int i = 0; i < 4; ++i) { const int q = F.tid + 512 * i, k = q >> 10, n = (q >> 3) & 127, dc = q & 7;
                const v4u v = *(const GAS v4u*)(SKb + ((size_t)((h * 2 + k) * 128 + n)) * 64 + 8 * dc);
                *(LAS v4u*)(F.lds + QPL_SK_OFF + (((k * 4 + (n >> 5)) * 4 + (dc >> 1)) * 64 + (dc & 1) * 32 + (n & 31)) * 16) = v; }
            LDS_WAIT(); __syncthreads();
            topk_item<true>(F, u.pm * 8 + F.wave, h, QPL_SK_OFF, QPL_SCR_OFF, 0);
            LDS_WAIT(); __syncthreads();
        }
    }
};
}
typedef unsigned char u8;
constexpr size_t WS_U8 = 18 * MiB, WS_V8 = 34 * MiB, WS_ACT = 50 * MiB, WS_XH8 = 58 * MiB, WS_XL8 = 74 * MiB, WS_P = 147 * MiB;
static_assert(WS_P + 64 * MiB <= WS_END && WS_XL8 + 16 * MiB <= WS_R1, "ws map (PEER)");
constexpr float PEER_TAB_SCALE = 256.0f, PEER_INV_SCALE = 1.0f / 256.0f;
#define MFMA16F8(a, b, c) __builtin_amdgcn_mfma_f32_16x16x32_fp8_fp8((a), (b), (c), 0, 0, 0)
__device__ __forceinline__ long mk64(unsigned lo, unsigned hi) { return (long)(((unsigned long long)hi << 32) | lo); }

struct PeerRows { v4u r[16]; };
struct PeerVTok { v4u av[2]; v4u ev[2]; };
template <int CTRL> __device__ __forceinline__ float dpp_mov(float v) { return __builtin_bit_cast(float, __builtin_amdgcn_update_dpp(0, __builtin_bit_cast(int, v), CTRL, 0xF, 0xF, true)); }
__device__ __forceinline__ void peer_u_meta(v4u (&ev)[2], const unsigned short* EXP, int t, int g8) {
#pragma unroll
    for (int k = 0; k < 2; ++k) ev[k] = *(const GAS v4u*)(EXP + (size_t)t * 128 + 16 * g8 + 8 * k);
}
typedef __amdgpu_buffer_rsrc_t peer_rsrc_t;
__device__ __forceinline__ v4u peer_ld_row(peer_rsrc_t rs, unsigned id, unsigned c16) { return __builtin_amdgcn_raw_buffer_load_b128(rs, (id << 7) | c16, 0, 0); }
__device__ __forceinline__ unsigned peer_id(const v4u (&ev)[2], int k) { const unsigned w = ev[k >> 3][(k >> 1) & 3]; return (k & 1) ? (w >> 16) : (w & 0xffffu); }
__device__ __forceinline__ void peer_rows16(PeerRows& R, peer_rsrc_t rs, unsigned c16, const v4u (&ev)[2]) {
#pragma unroll
    for (int k = 0; k < 16; ++k) R.r[k] = peer_ld_row(rs, peer_id(ev, k), c16);
}
__device__ __forceinline__ void peer_u_token(PeerRows& R, peer_rsrc_t rs, unsigned c16, const v4u (&enext)[2], v4u x0, v4u x1, unsigned* op, bool b0, bool b1, bool b2) {
    typedef _Float16 h2_t __attribute__((ext_vector_type(2)));
    h2_t xh[8];
    xh[0] = __builtin_bit_cast(h2_t, __builtin_amdgcn_cvt_pkrtz(blo(x0.x), bhi(x0.x))); xh[1] = __builtin_bit_cast(h2_t, __builtin_amdgcn_cvt_pkrtz(blo(x0.y), bhi(x0.y)));
    xh[2] = __builtin_bit_cast(h2_t, __builtin_amdgcn_cvt_pkrtz(blo(x0.z), bhi(x0.z))); xh[3] = __builtin_bit_cast(h2_t, __builtin_amdgcn_cvt_pkrtz(blo(x0.w), bhi(x0.w)));
    xh[4] = __builtin_bit_cast(h2_t, __builtin_amdgcn_cvt_pkrtz(blo(x1.x), bhi(x1.x))); xh[5] = __builtin_bit_cast(h2_t, __builtin_amdgcn_cvt_pkrtz(blo(x1.y), bhi(x1.y)));
    xh[6] = __builtin_bit_cast(h2_t, __builtin_amdgcn_cvt_pkrtz(blo(x1.z), bhi(x1.z))); xh[7] = __builtin_bit_cast(h2_t, __builtin_amdgcn_cvt_pkrtz(blo(x1.w), bhi(x1.w)));
    float d[16];
#pragma unroll
    for (int k = 0; k < 16; ++k) { const v4u rk = R.r[k];
        R.r[k] = peer_ld_row(rs, peer_id(enext, k), c16);
        float s0 = 0.f, s1 = 0.f;
#pragma unroll
        for (int dw = 0; dw < 4; ++dw) {
            s0 = __builtin_amdgcn_fdot2(__builtin_amdgcn_cvt_scalef32_pk_f16_fp8(rk[dw], 1.0f, false), xh[2 * dw], s0, false);
            s1 = __builtin_amdgcn_fdot2(__builtin_amdgcn_cvt_scalef32_pk_f16_fp8(rk[dw], 1.0f, true), xh[2 * dw + 1], s1, false); }
        d[k] = s0 + s1; }
    float r8[8], r4[4], r2[2];
#pragma unroll
    for (int i = 0; i < 8; ++i) { const float send = b0 ? d[i] : d[i + 8], keep = b0 ? d[i + 8] : d[i]; r8[i] = keep + dpp_mov<0xB1>(send); }
#pragma unroll
    for (int i = 0; i < 4; ++i) { const float send = b1 ? r8[i] : r8[i + 4], keep = b1 ? r8[i + 4] : r8[i]; r4[i] = keep + dpp_mov<0x4E>(send); }
#pragma unroll
    for (int i = 0; i < 2; ++i) { const float send = b2 ? r4[i] : r4[i + 2], keep = b2 ? r4[i + 2] : r4[i]; r2[i] = keep + __shfl_xor(send, 4); }
    *(GAS unsigned*)op = pk2(r2[0], r2[1]);
}
__device__ __forceinline__ void peer_u_phase(Frame& F) {
    const int lane = F.lane, w = F.wave, g8 = lane >> 3, c = lane & 7;
    const int x = blockIdx.x & 7, nj = F.G >> 3, j = blockIdx.x >> 3, tpw = T / nj;
    const peer_rsrc_t Us = __builtin_amdgcn_make_buffer_rsrc((void*)(F.ws + WS_U8 + (size_t)x * NEXP * 128), (short)0, NEXP * 128, 0x00020000); const unsigned c16 = 16u * (unsigned)c;
    const bf16* XN2 = (const bf16*)(F.ws + WS_R1) + 128 * x + 16 * c;
    const unsigned short* EXP = (const unsigned short*)(F.ws + WS_EXP); unsigned* P = (unsigned*)(F.ws + WS_P) + (size_t)x * T * 64;
    const bool b0 = lane & 1, b1 = lane & 2, b2 = lane & 4;
    const int slot = 16 * g8 + 8 * (b0 ? 1 : 0) + 4 * (b1 ? 1 : 0) + 2 * (b2 ? 1 : 0);
    const int nold = (tpw * 3) / 4, STR = 4;
    const int t0 = j * tpw + ((w < 4) ? w : nold + (w - 4)), tend = j * tpw + ((w < 4) ? nold : tpw);
    if (t0 >= tend) return;
#define TCL(tt) (((tt) < tend) ? (tt) : t0)
    v4u eA[2], eB[2]; PeerRows RA, RB;
    peer_u_meta(eA, EXP, t0, g8); peer_u_meta(eB, EXP, TCL(t0 + STR), g8);
    peer_rows16(RA, Us, c16, eA); peer_rows16(RB, Us, c16, eB);
    peer_u_meta(eA, EXP, TCL(t0 + 2 * STR), g8); peer_u_meta(eB, EXP, TCL(t0 + 3 * STR), g8);
#pragma unroll 1
    for (int t = t0; t < tend; t += 2 * STR) {
        const int tb = TCL(t + STR);
        const v4u xa0 = *(const GAS v4u*)(XN2 + (size_t)t * 1024), xa1 = *(const GAS v4u*)(XN2 + (size_t)t * 1024 + 8);
        const v4u xb0 = *(const GAS v4u*)(XN2 + (size_t)tb * 1024), xb1 = *(const GAS v4u*)(XN2 + (size_t)tb * 1024 + 8);
        peer_u_token(RA, Us, c16, eA, xa0, xa1, P + ((size_t)t * 128 + slot) / 2, b0, b1, b2);
        peer_u_meta(eA, EXP, TCL(t + 4 * STR), g8);
        if (t + STR < tend) peer_u_token(RB, Us, c16, eB, xb0, xb1, P + ((size_t)tb * 128 + slot) / 2, b0, b1, b2);
        peer_u_meta(eB, EXP, TCL(t + 5 * STR), g8);
    }
#undef TCL
}
__device__ __forceinline__ void peer_combine_phase(Frame& F) {
    const v2u* P = (const v2u*)(F.ws + WS_P); const float* GATE = (const float*)(F.ws + WS_GATE); v2u* ACT = (v2u*)(F.ws + WS_ACT); const float* RR = (const float*)(F.ws + WS_RROW);
    const int gt = F.vcu * (NWAVES * 64) + F.tid, NGT = F.G * NWAVES * 64;
    for (int i = gt; i < T * 32; i += NGT) {
        f32x4 s = {0.f, 0.f, 0.f, 0.f};
#pragma unroll
        for (int x = 0; x < 8; ++x) { const v2u w = *(const GAS v2u*)(P + (size_t)x * T * 32 + i); s += (f32x4){blo(w.x), bhi(w.x), blo(w.y), bhi(w.y)}; }
        const f32x4 g = *(const GAS f32x4*)(GATE + (size_t)i * 4);
        f32x4 o;
        const float rs = RR[i >> 5] * PEER_INV_SCALE;
        { const f32x2 g01 = gelu_pk((f32x2){s[0] * rs, s[1] * rs}), g23 = gelu_pk((f32x2){s[2] * rs, s[3] * rs});
          o[0] = g[0] * g01.x * PEER_INV_SCALE; o[1] = g[1] * g01.y * PEER_INV_SCALE; o[2] = g[2] * g23.x * PEER_INV_SCALE; o[3] = g[3] * g23.y * PEER_INV_SCALE; }
        v2u ow; ow.x = pk2(o[0], o[1]); ow.y = pk2(o[2], o[3]);
        *(GAS v2u*)(ACT + i) = ow;
    }
}
__device__ __forceinline__ void peer_v_meta(PeerVTok& M, const bf16* ACT, const unsigned short* EXP, int t, int g8) {
#pragma unroll
    for (int k = 0; k < 2; ++k) { M.av[k] = *(const GAS v4u*)(ACT + (size_t)t * 128 + 16 * g8 + 8 * k); M.ev[k] = *(const GAS v4u*)(EXP + (size_t)t * 128 + 16 * g8 + 8 * k); }
}
__device__ __forceinline__ void peer_v_rows(PeerRows& R, peer_rsrc_t rs, unsigned c16, const PeerVTok& M) {
#pragma unroll
    for (int k = 0; k < 16; ++k) R.r[k] = peer_ld_row(rs, peer_id(M.ev, k), c16);
}
__device__ __forceinline__ void peer_v_token(const PeerRows& R, const PeerVTok& M, f32x2 hres, float* op, bool b5, bool b4, bool b3) {
    f32x2 o[8];
#pragma unroll
    for (int p = 0; p < 8; ++p) o[p] = (f32x2){0.f, 0.f};
#pragma unroll
    for (int k = 0; k < 16; ++k) { const unsigned aw = M.av[k >> 3][(k >> 1) & 3]; const float a = (k & 1) ? bhi(aw) : blo(aw); const f32x2 aa = {a, a};
#pragma unroll
        for (int dw = 0; dw < 4; ++dw) {
            o[2 * dw] = __builtin_elementwise_fma(__builtin_amdgcn_cvt_pk_f32_fp8((int)R.r[k][dw], false), aa, o[2 * dw]);
            o[2 * dw + 1] = __builtin_elementwise_fma(__builtin_amdgcn_cvt_pk_f32_fp8((int)R.r[k][dw], true), aa, o[2 * dw + 1]); } }
    f32x2 q4[4], q2[2], q1;
#pragma unroll
    for (int i = 0; i < 4; ++i) { const f32x2 send = b5 ? o[i] : o[i + 4], keep = b5 ? o[i + 4] : o[i];
        q4[i] = (f32x2){keep.x + __shfl_xor(send.x, 32), keep.y + __shfl_xor(send.y, 32)}; }
#pragma unroll
    for (int i = 0; i < 2; ++i) { const f32x2 send = b4 ? q4[i] : q4[i + 2], keep = b4 ? q4[i + 2] : q4[i];
        q2[i] = (f32x2){keep.x + __shfl_xor(send.x, 16), keep.y + __shfl_xor(send.y, 16)}; }
    { const f32x2 send = b3 ? q2[0] : q2[1], keep = b3 ? q2[1] : q2[0]; q1 = (f32x2){keep.x + __shfl_xor(send.x, 8), keep.y + __shfl_xor(send.y, 8)}; }
    __builtin_nontemporal_store(hres + q1, (GAS f32x2*)op);
}
__device__ __forceinline__ void peer_v_phase(Frame& F, float* outp) {
    const int lane = F.lane, w = F.wave, g8 = lane >> 3, c = lane & 7;
    const int x = blockIdx.x & 7, nj = F.G >> 3, j = blockIdx.x >> 3, tpw = T / nj;
    const peer_rsrc_t Vs = __builtin_amdgcn_make_buffer_rsrc((void*)(F.ws + WS_V8 + (size_t)x * NEXP * 128), (short)0, NEXP * 128, 0x00020000); const unsigned c16 = 16u * (unsigned)c;
    const unsigned short* EXP = (const unsigned short*)(F.ws + WS_EXP); const bf16* ACT = (const bf16*)(F.ws + WS_ACT); const bf16* H1B = (const bf16*)(F.ws + WS_R1);
    const bool b5 = lane & 32, b4 = lane & 16, b3 = lane & 8;
    const int col = 128 * x + 16 * c + 8 * (b5 ? 1 : 0) + 4 * (b4 ? 1 : 0) + 2 * (b3 ? 1 : 0);
    const int nold = (tpw * 5) / 8, STR = 4;
    const int t0 = j * tpw + ((w < 4) ? w : nold + (w - 4)), tend = j * tpw + ((w < 4) ? nold : tpw);
    if (t0 >= tend) return;
    PeerVTok MA, MB; PeerRows RA, RB;
    peer_v_meta(MA, ACT, EXP, t0, g8); peer_v_rows(RA, Vs, c16, MA);
    { const int t1 = (t0 + STR < tend) ? t0 + STR : t0; peer_v_meta(MB, ACT, EXP, t1, g8); }
#pragma unroll 1
    for (int t = t0; t < tend; t += 2 * STR) {
        const int tb = (t + STR < tend) ? t + STR : t, tc = (t + 2 * STR < tend) ? t + 2 * STR : t, td = (t + 3 * STR < tend) ? t + 3 * STR : t;
        const unsigned hwa = __builtin_nontemporal_load((const GAS unsigned*)(H1B + (size_t)t * 1024 + col)), hwb = __builtin_nontemporal_load((const GAS unsigned*)(H1B + (size_t)tb * 1024 + col));
        const f32x2 ha = {blo(hwa), bhi(hwa)}, hb2 = {blo(hwb), bhi(hwb)};
        peer_v_rows(RB, Vs, c16, MB);
        peer_v_token(RA, MA, ha, outp + (size_t)t * 1024 + col, b5, b4, b3);
        peer_v_meta(MA, ACT, EXP, tc, g8); peer_v_rows(RA, Vs, c16, MA);
        if (t + STR < tend) peer_v_token(RB, MB, hb2, outp + (size_t)tb * 1024 + col, b5, b4, b3);
        peer_v_meta(MB, ACT, EXP, td, g8);
    }
}
struct Args { const float* in[25]; float* out; unsigned char* ws; int ph_lo, ph_hi, li, pad; };
enum { PH_P0 = 0, PH_GEMM1, PH_S5, PH_GLU, PH_BR1, PH_BR2, PH_OUT, PH_QP, PH_PEER_U, PH_PEER_C, PH_PEER_V, PH_COUNT };

__global__ void __launch_bounds__(NWAVES * 64, 2) mega_fwd(Args args) {
    extern __shared__ __attribute__((aligned(16))) unsigned char lds[];
    Frame F;
    F.lds = (LAS unsigned char*)lds;
    F.MISC = (volatile LAS unsigned*)(F.lds + MISC_OFF);
    F.tid = threadIdx.x; F.lane = F.tid & 63; F.wave = __builtin_amdgcn_readfirstlane(F.tid >> 6);
    F.G = gridDim.x; { const int bx = blockIdx.x; F.vcu = (F.G % 8 == 0) ? (bx % 8) * (F.G / 8) + bx / 8 : bx; }
    F.ws = args.ws; F.out = args.out; F.ctl = (gu32*)(args.ws + WS_CTL);
#pragma unroll
    for (int i = 0; i < 25; ++i) F.in[i] = args.in[i];
    for (int u = F.tid; u < (LDS_BYTES - LDSCTL_OFF) / 4; u += NWAVES * 64) ((LAS unsigned*)(F.lds + LDSCTL_OFF))[u] = 0u;
    __syncthreads();
    XcdBarrier bar = xcd_barrier_post((unsigned*)(F.ctl + CW_BAR) + args.li * XCD_BAR_WORDS, F.MISC + 8);
    const int lo = args.ph_lo, hi = args.ph_hi;
#ifndef PROBE_P0MASK
#define PROBE_P0MASK 15
#endif
#ifndef PROBE_S5VAR
#define PROBE_S5VAR 0
#endif
#ifndef PROBE_ATVAR
#define PROBE_ATVAR 0
#endif
#ifndef PROBE_REP
#define PROBE_REP -1
#endif
#define IN(k) (lo <= (k) && (k) < hi)
#ifdef STAMP_K
    F.st0 = 0; F.st1 = 0;
#define STAMP(k) do { if ((k) == STAMP_K) F.st0 = __builtin_amdgcn_s_memrealtime(); if ((k) == STAMP_K2) F.st1 = __builtin_amdgcn_s_memrealtime(); } while (0)
#else
#define STAMP(k) do { } while (0)
#endif
#define REPS(k) for (int rep_ = 0; rep_ < ((PROBE_REP == (k)) ? 2 : 1); ++rep_, (void)((PROBE_REP == (k) && rep_ == 1) ? (xcd_barrier(bar), 0) : 0))
#define SEAM(k) do { if (IN(k) && IN((k) + 1)) xcd_barrier(bar); } while (0)
    unsigned char* ws = F.ws;
    bf16* XB = (bf16*)(ws + WS_R1); bf16* ATT = XB; bf16* XN2 = XB;
    bf16* U5 = (bf16*)(ws + WS_U5); bf16* Qb = (bf16*)(ws + WS_Q); bf16* Kb = (bf16*)(ws + WS_K); bf16* Vb = (bf16*)(ws + WS_V);
    bf16* Gt = (bf16*)F.out;
    bf16* YS5 = (bf16*)(ws + WS_YS5); bf16* S5Gb = (bf16*)(ws + WS_S5G); bf16* MIX = (bf16*)(ws + WS_MIX); bf16* QP = (bf16*)(ws + WS_QP);

    STAMP(PH_P0);
    if (IN(PH_P0)) REPS(PH_P0) { p0_prologue(F, rep_ ? PROBE_P0MASK : 15); VM_WAIT(); __syncthreads(); } SEAM(PH_P0);

    STAMP(PH_GEMM1);
    if (IN(PH_GEMM1)) REPS(PH_GEMM1) {
        pg8::Gemm g{XB, (const bf16*)(ws + WS_W1T), T, INW, D}; pg8::StaticOrder S; S.init(T, INW, F.G, (int)blockIdx.x);
        pg8::EpiProj E{U5, Qb, Kb, Vb, Gt, F.in[I_BGATE]};
        pg8::gemm_phase<pg8::EpiProj, pg8::StaticOrder, true, true>(F.lds, g, S, E);
    }
    ConvPipe CP;
    if (IN(PH_S5)) { conv_init(F, CP); conv_issue(F, CP, 0); }
    SEAM(PH_GEMM1);

    STAMP(PH_S5);
    if (IN(PH_S5)) REPS(PH_S5) { mixers_phase(F, CP); }

    STAMP(PH_GLU);
    if (IN(PH_GLU)) REPS(PH_GLU) {
        pg8::Gemm g{YS5, (const bf16*)(ws + WS_WGLUT), T, 1024, 512}; pg8::StaticOrder S; S.init(T, 1024, F.G, (int)blockIdx.x);
        pg8::EpiGlu E{S5Gb};
        pg8::gemm_phase<pg8::EpiGlu, pg8::StaticOrder, true, true>(F.lds, g, S, E);
    } SEAM(PH_GLU);

    STAMP(PH_BR2);
    if (IN(PH_BR2)) REPS(PH_BR2) {
        pg8::Gemm g{S5Gb, (const bf16*)(ws + WS_WS5T), T, 1024, 1536, ATT, 512}; pg8::StaticOrder S; S.init(T, 1024, F.G, (int)blockIdx.x);
        pg8::EpiGateDual E{MIX, 1024, Gt};
        pg8::gemm_phase<pg8::EpiGateDual, pg8::StaticOrder, true, true, true>(F.lds, g, S, E);
    } SEAM(PH_BR2);

    STAMP(PH_OUT);
    if (IN(PH_OUT)) REPS(PH_OUT) {
        pg8::Gemm g{MIX, (const bf16*)(ws + WS_WOUT), T, 1024, 1024}; pg8::StaticOrder S; S.init(T, 1024, F.G, (int)blockIdx.x);
        pg8::EpiRes E{F.in[I_X], F.out, XN2, (float*)(ws + WS_SSQ)};
        pg8::gemm_phase<pg8::EpiRes, pg8::StaticOrder, true, true>(F.lds, g, S, E);
    } SEAM(PH_OUT);

    STAMP(PH_QP);
    if (IN(PH_QP)) REPS(PH_QP) {
        pg8::Gemm g{XN2, (const bf16*)(ws + WS_WQT), T, 1024, 1024}; pg8::StaticOrder S; S.init(T, 1024, F.G, (int)blockIdx.x);
        LAS float* rrow = (LAS float*)(F.lds + RROW_OFF);
        { pg8::Unit u0; if (S.next(0, u0) && F.tid < 256) { const int row = u0.pm * 256 + F.tid; const float* sp = (const float*)(ws + WS_SSQ) + (size_t)row * 16;
            const f32x4 a0 = *(const GAS f32x4*)sp, a1 = *(const GAS f32x4*)(sp + 4), a2 = *(const GAS f32x4*)(sp + 8), a3 = *(const GAS f32x4*)(sp + 12);
            const float ssum = ((a0[0] + a0[1]) + (a0[2] + a0[3])) + ((a1[0] + a1[1]) + (a1[2] + a1[3])) + ((a2[0] + a2[1]) + (a2[2] + a2[3])) + ((a3[0] + a3[1]) + (a3[2] + a3[3]));
            const float r = rsqrtf(ssum * (1.0f / D) + RMS_EPS); rrow[F.tid] = r; if (u0.pn == 0) ((float*)(ws + WS_RROW))[row] = r; } }
        LDS_WAIT(); __syncthreads();
        pg8::EpiQpTopk E{&F, rrow};
        pg8::gemm_phase<pg8::EpiQpTopk, pg8::StaticOrder, true, true>(F.lds, g, S, E);
    } SEAM(PH_QP);

    #ifndef PROBE_UVAR
#define PROBE_UVAR 0
#endif
    STAMP(PH_PEER_U);
    if (IN(PH_PEER_U)) REPS(PH_PEER_U) { peer_u_phase(F); } SEAM(PH_PEER_U);
    STAMP(PH_PEER_C);
    if (IN(PH_PEER_C)) REPS(PH_PEER_C) { peer_combine_phase(F); } SEAM(PH_PEER_C);
    STAMP(PH_PEER_V);
    if (IN(PH_PEER_V)) REPS(PH_PEER_V) { peer_v_phase(F, rep_ ? (float*)(ws + WS_P) : F.out); }
    STAMP(PH_COUNT);
#ifdef STAMP_K
    VM_WAIT(); __syncthreads();
    if (blockIdx.x == 0 && F.tid == 0) atomicAdd(F.out + 5, (float)(F.st1 - F.st0) * 1e-4f);
#endif
#undef IN
#undef SEAM
}
static void launch_mega(Args a, int lo, int hi, int li, int grid, hipStream_t stream) {
    a.ph_lo = lo; a.ph_hi = hi; a.li = li; a.pad = 0;
    hipLaunchKernelGGL(mega_fwd, dim3(grid), dim3(NWAVES * 64), LDS_BYTES, stream, a);
}
extern "C" void kernel_launch(void* const* d_in, const int* in_sizes, int n_in, void* d_out, int out_size, void* d_ws, size_t ws_size, hipStream_t stream) {
    static int grid = 0;
    if (grid == 0) {
        if (n_in != 25 || out_size != T * D || ws_size < WS_END) { fprintf(stderr, "kernel_launch: unexpected shapes n_in %d out %d ws %zu\n", n_in, out_size, ws_size); grid = -1; return; }
        int dev = 0, cus = 0, per_cu = 0;
        if (hipGetDevice(&dev) != hipSuccess || hipDeviceGetAttribute(&cus, hipDeviceAttributeMultiprocessorCount, dev) != hipSuccess) { grid = -1; return; }
        if (hipFuncSetAttribute((const void*)mega_fwd, hipFuncAttributeMaxDynamicSharedMemorySize, LDS_BYTES) != hipSuccess) { fprintf(stderr, "kernel_launch: hipFuncSetAttribute failed\n"); grid = -1; return; }
        if (hipOccupancyMaxActiveBlocksPerMultiprocessor(&per_cu, (const void*)mega_fwd, NWAVES * 64, LDS_BYTES) != hipSuccess || per_cu < 1) { fprintf(stderr, "kernel_launch: occupancy query says %d\n", per_cu); grid = -1; (void)hipGetLastError(); return; }
        if (cus != 256) { fprintf(stderr, "kernel_launch: built for a 256-CU device (one 256x256 GEMM unit per workgroup in the N = 1024 phases), found %d CUs\n", cus); grid = -1; return; }
        grid = cus;
    }
    if (grid < 0) return;
    if (hipMemsetAsync((char*)d_ws + WS_CTL, 0, CTL_ZERO_BYTES, stream) != hipSuccess) { fprintf(stderr, "kernel_launch: memset failed\n"); return; }
    Args a{};
    for (int i = 0; i < 25; ++i) a.in[i] = (const float*)d_in[i];
    a.out = (float*)d_out; a.ws = (unsigned char*)d_ws;
    launch_mega(a, PH_P0, PH_COUNT, 0, grid, stream);
}
```
